# Optimizing an MI355X kernel written in HIP

```python
import jax, jax.numpy as jnp
from jax import lax
import numpy as np

D_MODEL = 1024
BATCH = 1
SEQ = 16384
DEPTH = 1

GRID_W = 64
MEM_LEN = 256
HEAD_DIM = 64
NA_HEADS = 8
NA_WIDTH = NA_HEADS * HEAD_DIM
CONV_WIDTH = D_MODEL - NA_WIDTH
MIX_WIDTH = NA_WIDTH + CONV_WIDTH
CONV_K = 3
NA_WIN_ROWS = 8
NA_WIN_COLS = 16
MEM_HEADS = 4
MEM_HEAD_DIM = 128
MEM_WIDTH = MEM_HEADS * MEM_HEAD_DIM
N_EXPERTS = 16
EC_CAPACITY_FACTOR = 2
EXPERT_FF = 2048
LN_EPS = 1e-5
DN_ALPHA = (2 * DEPTH) ** 0.25
DN_BETA = (8 * DEPTH) ** -0.25

kernel_name = "hybrid_na2d_shortconv_memxattn_ecmoe"


def layer_norm(x, g, b):
    xf = x.astype(jnp.float32)
    mu = jnp.mean(xf, axis=-1, keepdims=True)
    var = jnp.mean(jnp.square(xf - mu), axis=-1, keepdims=True)
    return ((xf - mu) * lax.rsqrt(var + LN_EPS)).astype(x.dtype) * g + b


def window_starts(n, win):
    return jnp.clip(jnp.arange(n) - win // 2, 0, n - win)


def neighbourhood_attention(q, k, v, rpb):
    B, S, H, Dh = q.shape
    rows = S // GRID_W
    kr = min(NA_WIN_ROWS, rows)
    kc = NA_WIN_COLS
    qg = q.reshape(B, rows, GRID_W, H, Dh)
    kg = k.reshape(B, rows, GRID_W, H, Dh)
    vg = v.reshape(B, rows, GRID_W, H, Dh)
    row_idx = window_starts(rows, kr)[:, None] + jnp.arange(kr)[None, :]
    k_rows = kg[:, row_idx]
    v_rows = vg[:, row_idx]
    scores = jnp.einsum('brqhd,brjkhd->bhrqjk', qg, k_rows,
                        preferred_element_type=jnp.float32) * (Dh ** -0.5)
    dr_idx = row_idx - jnp.arange(rows)[:, None] + (NA_WIN_ROWS - 1)
    cols = jnp.arange(GRID_W)
    dc = cols[None, :] - cols[:, None]
    dc_idx = jnp.clip(dc, -(kc - 1), kc - 1) + (kc - 1)
    c_start = window_starts(GRID_W, kc)[:, None]
    col_mask = (cols[None, :] >= c_start) & (cols[None, :] < c_start + kc)
    bias = rpb[:, dr_idx[:, None, :, None], dc_idx[None, :, None, :]]
    scores = scores + bias[None].astype(jnp.float32)
    scores = jnp.where(col_mask[:, None, :], scores, jnp.finfo(jnp.float32).min)
    probs = jax.nn.softmax(scores.reshape(B, H, rows, GRID_W, kr * GRID_W), axis=-1)
    probs = probs.reshape(B, H, rows, GRID_W, kr, GRID_W).astype(v.dtype)
    out = jnp.einsum('bhrqjk,brjkhd->brqhd', probs, v_rows)
    return out.reshape(B, S, H * Dh)


def short_conv(u, w):
    rhs = w[:, None, :].astype(u.dtype)
    return lax.conv_general_dilated(u, rhs, window_strides=(1,),
                                    padding=[(CONV_K // 2, CONV_K // 2)],
                                    dimension_numbers=('NWC', 'WIO', 'NWC'),
                                    feature_group_count=u.shape[-1])


def hybrid_mixer(x, w_in, rpb, conv_w, w_out):
    B, S, _ = x.shape
    proj = x @ w_in
    splits = [NA_WIDTH, 2 * NA_WIDTH, 3 * NA_WIDTH,
              3 * NA_WIDTH + CONV_WIDTH, 3 * NA_WIDTH + 2 * CONV_WIDTH]
    q, k, v, b_gate, c_gate, h = jnp.split(proj, splits, axis=-1)
    heads = lambda t: t.reshape(B, S, NA_HEADS, HEAD_DIM)
    y_na = neighbourhood_attention(heads(q), heads(k), heads(v), rpb)
    y_conv = b_gate * short_conv(c_gate * h, conv_w)
    return jnp.concatenate([y_na, y_conv], axis=-1) @ w_out


def memory_cross_attention(x, mem, wq, wk, wv, wo):
    B, S, _ = x.shape
    M = mem.shape[1]
    q = (x @ wq).reshape(B, S, MEM_HEADS, MEM_HEAD_DIM)
    k = (mem @ wk).reshape(B, M, MEM_HEADS, MEM_HEAD_DIM)
    v = (mem @ wv).reshape(B, M, MEM_HEADS, MEM_HEAD_DIM)
    s = jnp.einsum('bshd,bmhd->bhsm', q, k,
                   preferred_element_type=jnp.float32) * (MEM_HEAD_DIM ** -0.5)
    p = jax.nn.softmax(s, axis=-1).astype(v.dtype)
    o = jnp.einsum('bhsm,bmhd->bshd', p, v).reshape(B, S, MEM_WIDTH)
    return o @ wo


def expert_choice_moe(x, w_router, w_gate, w_up, w_down):
    B, S, D = x.shape
    cap = EC_CAPACITY_FACTOR * S // N_EXPERTS
    logits = jnp.einsum('bsd,de->bse', x, w_router, preferred_element_type=jnp.float32)
    affinity = jax.nn.softmax(logits, axis=-1)
    gates, idx = lax.top_k(jnp.swapaxes(affinity, 1, 2), cap)
    xe = jax.vmap(lambda xb, ib: xb[ib])(x, idx)
    hid = jax.nn.silu(jnp.einsum('becd,edf->becf', xe, w_gate)) * \
        jnp.einsum('becd,edf->becf', xe, w_up)
    ye = jnp.einsum('becf,efd->becd', hid, w_down) * gates[..., None].astype(x.dtype)
    scatter = lambda ib, yb: jnp.zeros((S, D), yb.dtype).at[ib.reshape(-1)].add(yb.reshape(-1, D))
    return jax.vmap(scatter)(idx, ye)


def setup_inputs(seed: int = 0) -> dict:
    key = jax.random.key(seed)
    ks = jax.random.split(key, 20)
    nrm = lambda k, shape, scale: jax.random.normal(k, shape, jnp.float32) * scale
    L = DEPTH
    return {
        "x": nrm(ks[0], (BATCH, SEQ, D_MODEL), 1.0),
        "mem": nrm(ks[1], (BATCH, MEM_LEN, D_MODEL), 1.0),
        "w_in": nrm(ks[2], (L, D_MODEL, 3 * NA_WIDTH + 3 * CONV_WIDTH), D_MODEL ** -0.5),
        "na_rpb": nrm(ks[3], (L, NA_HEADS, 2 * NA_WIN_ROWS - 1, 2 * NA_WIN_COLS - 1), 0.1),
        "conv_w": nrm(ks[4], (L, CONV_K, CONV_WIDTH), CONV_K ** -0.5),
        "w_mix_out": nrm(ks[5], (L, MIX_WIDTH, D_MODEL), MIX_WIDTH ** -0.5 * DN_BETA),
        "ln1_g": 1.0 + nrm(ks[6], (L, D_MODEL), 0.02),
        "ln1_b": nrm(ks[7], (L, D_MODEL), 0.02),
        "w_mem_q": nrm(ks[8], (L, D_MODEL, MEM_WIDTH), D_MODEL ** -0.5),
        "w_mem_k": nrm(ks[9], (L, D_MODEL, MEM_WIDTH), D_MODEL ** -0.5),
        "w_mem_v": nrm(ks[10], (L, D_MODEL, MEM_WIDTH), D_MODEL ** -0.5),
        "w_mem_out": nrm(ks[11], (L, MEM_WIDTH, D_MODEL), MEM_WIDTH ** -0.5 * DN_BETA),
        "ln2_g": 1.0 + nrm(ks[12], (L, D_MODEL), 0.02),
        "ln2_b": nrm(ks[13], (L, D_MODEL), 0.02),
        "w_router": nrm(ks[14], (L, D_MODEL, N_EXPERTS), D_MODEL ** -0.5),
        "w_exp_gate": nrm(ks[15], (L, N_EXPERTS, D_MODEL, EXPERT_FF), D_MODEL ** -0.5),
        "w_exp_up": nrm(ks[16], (L, N_EXPERTS, D_MODEL, EXPERT_FF), D_MODEL ** -0.5),
        "w_exp_down": nrm(ks[17], (L, N_EXPERTS, EXPERT_FF, D_MODEL), EXPERT_FF ** -0.5 * DN_BETA),
        "ln3_g": 1.0 + nrm(ks[18], (L, D_MODEL), 0.02),
        "ln3_b": nrm(ks[19], (L, D_MODEL), 0.02),
    }


def reference(x, mem, w_in, na_rpb, conv_w, w_mix_out, ln1_g, ln1_b,
              w_mem_q, w_mem_k, w_mem_v, w_mem_out, ln2_g, ln2_b,
              w_router, w_exp_gate, w_exp_up, w_exp_down, ln3_g, ln3_b):
    for l in range(DEPTH):
        x = layer_norm(DN_ALPHA * x + hybrid_mixer(x, w_in[l], na_rpb[l], conv_w[l], w_mix_out[l]),
                       ln1_g[l], ln1_b[l])
        x = layer_norm(DN_ALPHA * x + memory_cross_attention(x, mem, w_mem_q[l], w_mem_k[l],
                                                             w_mem_v[l], w_mem_out[l]),
                       ln2_g[l], ln2_b[l])
        x = layer_norm(DN_ALPHA * x + expert_choice_moe(x, w_router[l], w_exp_gate[l],
                                                        w_exp_up[l], w_exp_down[l]),
                       ln3_g[l], ln3_b[l])
    return x
```

```cpp
#include <hip/hip_runtime.h>
#include <hip/hip_cooperative_groups.h>
#include <cstdio>
#include <cstdint>
namespace cg = cooperative_groups;

#define LAS __attribute__((address_space(3)))
typedef unsigned short bf16_t;
typedef short bf16x8 __attribute__((ext_vector_type(8)));
typedef float f32x4 __attribute__((ext_vector_type(4)));
typedef float f32x2 __attribute__((ext_vector_type(2)));
typedef unsigned u32x4 __attribute__((ext_vector_type(4)));
typedef unsigned u32x2 __attribute__((ext_vector_type(2)));
typedef __bf16 bfv2 __attribute__((ext_vector_type(2)));

constexpr int SEQ = 16384, DM = 1024, MEMLEN = 256, NEXP = 16, CAP = 2048, FF = 2048;
constexpr float ALPHA = 1.189207115002721f;
constexpr float LNEPS = 1e-5f;
constexpr size_t MiB = 1u << 20;
constexpr size_t OFF_WIN = 0, OFF_WOUT = 6 * MiB, OFF_WQ = 8 * MiB, OFF_WK = 9 * MiB, OFF_WV = 10 * MiB, OFF_WMO = 11 * MiB,
                 OFF_MEMB = 12 * MiB, OFF_KMEM = 12 * MiB + 512 * 1024, OFF_VMEMT = 12 * MiB + 768 * 1024,
                 OFF_AFFT = 13 * MiB, OFF_INV = 14 * MiB, OFF_IDX = 15 * MiB, OFF_GATE = 15 * MiB + 128 * 1024,
                 OFF_WGU = 16 * MiB, OFF_WD = 144 * MiB,
                 OFF_RA = 208 * MiB, OFF_QK = OFF_RA, OFF_VT = 240 * MiB, OFF_GT = 256 * MiB, OFF_Y = 304 * MiB, OFF_HID = OFF_RA,
                 OFF_RB = 336 * MiB,
                 OFF_XB = 400 * MiB,
                 OFF_Q2 = 432 * MiB, OFF_O = 448 * MiB, OFF_X2B = OFF_Q2,
                 WS_END = 464 * MiB;
constexpr int LDS_BYTES = 136 * 1024;

struct Params {
    const float *x, *mem, *w_in, *rpb, *conv_w, *w_out, *ln1g, *ln1b, *wq, *wk, *wv, *wmo, *ln2g, *ln2b, *w_router, *weg, *weu, *wed, *ln3g, *ln3b;
    float* out; unsigned char* ws;
};

__device__ __forceinline__ unsigned pk2(float a, float b) { f32x2 f = {a, b}; bfv2 r = __builtin_convertvector(f, bfv2); return __builtin_bit_cast(unsigned, r); }
__device__ __forceinline__ float bflo(unsigned w) { return __uint_as_float(w << 16); }
__device__ __forceinline__ float bfhi(unsigned w) { return __uint_as_float(w & 0xffff0000u); }
__device__ __forceinline__ float wave_sum(float v) {
#pragma unroll
    for (int o = 1; o < 64; o <<= 1) v += __shfl_xor(v, o);
    return v;
}

namespace pg8 {
constexpr int BM = 256, BK = 64, HALF = 128, HTB = HALF * BK * 2, STAGE_BYTES = 8 * HTB;
__device__ __forceinline__ int lds_byte(int r, int c) { const int st = (r >> 4) * 2 + (c >> 5), rr = r & 15, cc = c & 31, ob = rr * 64 + cc * 2; return st * 1024 + (ob ^ (((ob >> 9) & 1) << 5)); }
__device__ __forceinline__ void stage_rc(int b, int& R, int& C) { const int st = b / 1024, sb = b % 1024, swz = sb ^ (((sb >> 9) & 1) << 5); R = (st >> 1) * 16 + swz / 64; C = (st & 1) * 32 + (swz % 64) / 2; }
__device__ __forceinline__ int perm32(int rho) { const int n = rho >> 4, i = rho & 15; return 8 * (i >> 2) + 4 * n + (i & 3); }

struct Unit { const char* A; const char* B; char* O; const char* R; int ldc; int aux; };

struct EpiBf16 {
    static constexpr bool PERM = true;
    __device__ __forceinline__ void operator()(const f32x4 (&acc)[2][2][4][2], const Unit& u, int wr, int wc, int fr, int fq) const {
        bf16_t* O = (bf16_t*)u.O;
#pragma unroll
        for (int ai = 0; ai < 2; ++ai)
#pragma unroll
            for (int m = 0; m < 4; ++m) {
                bf16_t* rowp = O + (size_t)(ai * 128 + wr * 64 + m * 16 + fr) * u.ldc + wc * 32 + 8 * fq;
#pragma unroll
                for (int bj = 0; bj < 2; ++bj) {
                    const f32x4 a0 = acc[ai][bj][m][0], a1 = acc[ai][bj][m][1];
                    u32x4 o; o.x = pk2(a0[0], a0[1]); o.y = pk2(a0[2], a0[3]); o.z = pk2(a1[0], a1[1]); o.w = pk2(a1[2], a1[3]);
                    *(u32x4*)(rowp + bj * 128) = o;
                }
            }
    }
};
struct EpiGate {
    static constexpr bool PERM = true;
    const float* gate;
    __device__ __forceinline__ void operator()(const f32x4 (&acc)[2][2][4][2], const Unit& u, int wr, int wc, int fr, int fq) const {
        bf16_t* O = (bf16_t*)u.O;
#pragma unroll
        for (int ai = 0; ai < 2; ++ai)
#pragma unroll
            for (int m = 0; m < 4; ++m) {
                const int row = ai * 128 + wr * 64 + m * 16 + fr;
                const float gt = gate[u.aux + row];
                bf16_t* rowp = O + (size_t)row * u.ldc + wc * 32 + 8 * fq;
#pragma unroll
                for (int bj = 0; bj < 2; ++bj) {
                    const f32x4 a0 = acc[ai][bj][m][0] * gt, a1 = acc[ai][bj][m][1] * gt;
                    u32x4 o; o.x = pk2(a0[0], a0[1]); o.y = pk2(a0[2], a0[3]); o.z = pk2(a1[0], a1[1]); o.w = pk2(a1[2], a1[3]);
                    *(u32x4*)(rowp + bj * 128) = o;
                }
            }
    }
};
struct EpiRes {
    static constexpr bool PERM = false;
    __device__ __forceinline__ void operator()(const f32x4 (&acc)[2][2][4][2], const Unit& u, int wr, int wc, int fr, int fq) const {
        float* Z = (float*)u.O; const float* R = (const float*)u.R;
#pragma unroll
        for (int ai = 0; ai < 2; ++ai)
#pragma unroll
            for (int m = 0; m < 4; ++m) {
                const size_t ro = (size_t)(ai * 128 + wr * 64 + m * 16 + fr) * u.ldc + wc * 32 + 4 * fq;
#pragma unroll
                for (int bj = 0; bj < 2; ++bj)
#pragma unroll
                    for (int n = 0; n < 2; ++n) {
                        const f32x4 r = *(const f32x4*)(R + ro + bj * 128 + n * 16);
                        *(f32x4*)(Z + ro + bj * 128 + n * 16) = acc[ai][bj][m][n] + r * ALPHA;
                    }
            }
    }
};
__device__ __forceinline__ float swi(float g, float u) { return g * u / (1.f + __expf(-g)); }
struct EpiSwiGLU {
    static constexpr bool PERM = true;
    __device__ __forceinline__ void operator()(const f32x4 (&acc)[2][2][4][2], const Unit& u, int wr, int wc, int fr, int fq) const {
        bf16_t* O = (bf16_t*)u.O;
#pragma unroll
        for (int ai = 0; ai < 2; ++ai)
#pragma unroll
            for (int m = 0; m < 4; ++m) {
                bf16_t* rowp = O + (size_t)(ai * 128 + wr * 64 + m * 16 + fr) * u.ldc + wc * 32 + 8 * fq;
                const f32x4 g0 = acc[ai][0][m][0], g1 = acc[ai][0][m][1], u0 = acc[ai][1][m][0], u1 = acc[ai][1][m][1];
                u32x4 o;
                o.x = pk2(swi(g0[0], u0[0]), swi(g0[1], u0[1])); o.y = pk2(swi(g0[2], u0[2]), swi(g0[3], u0[3]));
                o.z = pk2(swi(g1[0], u1[0]), swi(g1[1], u1[1])); o.w = pk2(swi(g1[2], u1[2]), swi(g1[3], u1[3]));
                *(u32x4*)rowp = o;
            }
    }
};

template <class Epi, class Sched>
__device__ __forceinline__ void gemm_phase(LAS unsigned char* lds, const int K, const Sched& S, const Epi& E) {
    const int tid = threadIdx.x, wid = __builtin_amdgcn_readfirstlane(tid >> 6), lane = tid & 63, wr = wid >> 2, wc = wid & 3, fr = lane & 15, fq = lane >> 4;
    const int nt = K / BK;
    unsigned voffA[2], voffB[2];
#pragma unroll
    for (int i = 0; i < 2; ++i) { int R, C; stage_rc(tid * 16 + i * 8192, R, C); const int Rb = Epi::PERM ? ((R & ~31) + perm32(R & 31)) : R;
        voffA[i] = (unsigned)(R * K + C) * 2u; voffB[i] = (unsigned)(Rb * K + C) * 2u; }
    const size_t kstep = (size_t)(BK * 2);
    const size_t hstep = (size_t)HALF * K * 2;
    const unsigned ldsw = (unsigned)wid * 1024u;
    const int aoff = lds_byte(wr * 64 + fr, fq * 8), boff = lds_byte(wc * 32 + fr, fq * 8);
#define PG8_SA(b, h) (((b) * 2 + (h)) * HTB)
#define PG8_SB(b, h) ((4 + (b) * 2 + (h)) * HTB)
#define PG8_STAGE(bufoff, gbase, voff) do { _Pragma("unroll") for (int _i = 0; _i < 2; ++_i) \
        __builtin_amdgcn_global_load_lds((const unsigned*)((const char*)(gbase) + (voff)[_i]), (LAS unsigned*)(lds + (bufoff) + ldsw + _i * 8192), 16, 0, 0); } while (0)
#define PG8_LDA(dst, b, h) do { _Pragma("unroll") for (int m = 0; m < 4; ++m) _Pragma("unroll") for (int k = 0; k < 2; ++k) dst[m][k] = *(const LAS bf16x8*)(lds + PG8_SA(b, h) + aoff + m * 2048 + k * 1024); } while (0)
#define PG8_LDB(dst, b, h) do { _Pragma("unroll") for (int n = 0; n < 2; ++n) _Pragma("unroll") for (int k = 0; k < 2; ++k) dst[n][k] = *(const LAS bf16x8*)(lds + PG8_SB(b, h) + boff + n * 2048 + k * 1024); } while (0)
#define PG8_MMA(ai, bj, At, Bt) do { __builtin_amdgcn_s_setprio(1); _Pragma("unroll") for (int m = 0; m < 4; ++m) _Pragma("unroll") for (int n = 0; n < 2; ++n) _Pragma("unroll") for (int k = 0; k < 2; ++k) \
        acc[ai][bj][m][n] = __builtin_amdgcn_mfma_f32_16x16x32_bf16(Bt[n][k], At[m][k], acc[ai][bj][m][n], 0, 0, 0); __builtin_amdgcn_s_setprio(0); } while (0)
#define PG8_WAIT_V(n) asm volatile("s_waitcnt vmcnt(" #n ")" ::: "memory")
#define PG8_WAIT_L(n) asm volatile("s_waitcnt lgkmcnt(" #n ")" ::: "memory")
#define PG8_BAR __builtin_amdgcn_s_barrier()
#define PG8_SCHED __builtin_amdgcn_sched_barrier(0)
    Unit cur, nxt; int ui = 0;
    if (!S.next(0, cur)) return;
    f32x4 acc[2][2][4][2];
#pragma unroll
    for (int a = 0; a < 2; ++a)
#pragma unroll
        for (int b = 0; b < 2; ++b)
#pragma unroll
            for (int m = 0; m < 4; ++m)
#pragma unroll
                for (int n = 0; n < 2; ++n) acc[a][b][m][n] = (f32x4){0.f, 0.f, 0.f, 0.f};
    bf16x8 At[4][2], B0[2][2], B1[2][2];
    const char* cA = cur.A; const char* cB = cur.B;
    PG8_STAGE(PG8_SB(0, 0), cB, voffB); PG8_STAGE(PG8_SA(0, 0), cA, voffA); PG8_STAGE(PG8_SB(0, 1), cB + hstep, voffB); PG8_STAGE(PG8_SA(0, 1), cA + hstep, voffA);
    if (wr == 1) PG8_BAR;
    PG8_WAIT_V(4); PG8_BAR;
    PG8_STAGE(PG8_SB(1, 0), cB + kstep, voffB); PG8_STAGE(PG8_SA(1, 0), cA + kstep, voffA); PG8_STAGE(PG8_SB(1, 1), cB + hstep + kstep, voffB);
    PG8_WAIT_V(6); PG8_BAR;
    for (;;) {
        const bool has_next = S.next(ui + 1, nxt);
        const char* nA = has_next ? nxt.A : cA; const char* nB = has_next ? nxt.B : cB;
        for (int t = 0; t < nt; t += 2) {
            const bool last = (t == nt - 2);
            const char* a1 = cA + (size_t)(t + 1) * kstep;
            const char* a2 = last ? nA : cA + (size_t)(t + 2) * kstep; const char* b2 = last ? nB : cB + (size_t)(t + 2) * kstep;
            const char* a3 = a2 + kstep; const char* b3 = b2 + kstep;
            PG8_LDB(B0, 0, 0); PG8_SCHED; PG8_LDA(At, 0, 0); PG8_STAGE(PG8_SA(1, 1), a1 + hstep, voffA);
            PG8_WAIT_L(8); PG8_BAR; PG8_WAIT_L(0); PG8_MMA(0, 0, At, B0); PG8_BAR; PG8_SCHED;
            PG8_LDB(B1, 0, 1); PG8_STAGE(PG8_SB(0, 0), b2, voffB);
            PG8_BAR; PG8_WAIT_L(0); PG8_MMA(0, 1, At, B1); PG8_BAR;
            PG8_LDA(At, 0, 1); PG8_STAGE(PG8_SA(0, 0), a2, voffA);
            PG8_BAR; PG8_WAIT_L(0); PG8_MMA(1, 0, At, B0); PG8_BAR; PG8_SCHED;
            PG8_STAGE(PG8_SB(0, 1), b2 + hstep, voffB);
            PG8_WAIT_V(6); PG8_BAR; PG8_MMA(1, 1, At, B1); PG8_BAR;
            PG8_LDB(B0, 1, 0); PG8_SCHED; PG8_LDA(At, 1, 0); PG8_STAGE(PG8_SA(0, 1), a2 + hstep, voffA);
            PG8_WAIT_L(8); PG8_BAR; PG8_WAIT_L(0); PG8_MMA(0, 0, At, B0); PG8_BAR; PG8_SCHED;
            PG8_LDB(B1, 1, 1); PG8_STAGE(PG8_SB(1, 0), b3, voffB);
            PG8_BAR; PG8_WAIT_L(0); PG8_MMA(0, 1, At, B1); PG8_BAR;
            PG8_LDA(At, 1, 1); PG8_STAGE(PG8_SA(1, 0), a3, voffA);
            PG8_BAR; PG8_WAIT_L(0); PG8_MMA(1, 0, At, B0); PG8_BAR; PG8_SCHED;
            PG8_STAGE(PG8_SB(1, 1), b3 + hstep, voffB);
            PG8_WAIT_V(6); PG8_BAR; PG8_MMA(1, 1, At, B1); PG8_BAR;
        }
        E(acc, cur, wr, wc, fr, fq);
        if (!has_next) break;
#pragma unroll
        for (int a = 0; a < 2; ++a)
#pragma unroll
            for (int b = 0; b < 2; ++b)
#pragma unroll
                for (int m = 0; m < 4; ++m)
#pragma unroll
                    for (int n = 0; n < 2; ++n) acc[a][b][m][n] = (f32x4){0.f, 0.f, 0.f, 0.f};
        cur = nxt; cA = nA; cB = nB; ++ui;
    }
    PG8_WAIT_V(0);
    if (wr == 0) PG8_BAR;
    PG8_BAR;
#undef PG8_SA
#undef PG8_SB
#undef PG8_STAGE
#undef PG8_LDA
#undef PG8_LDB
#undef PG8_MMA
#undef PG8_WAIT_V
#undef PG8_WAIT_L
#undef PG8_BAR
#undef PG8_SCHED
}
}
using pg8::Unit;

struct SchedG1 {
    const char *xb, *win; char *qk, *vt, *gt; int G, c;
    __device__ __forceinline__ bool next(int i, Unit& u) const {
        const int L = i * G + c; if (L >= 768) return false;
        u.R = nullptr; u.aux = 0;
        if (L < 640) { const int pm = L / 10, pn = L % 10; u.A = xb + (size_t)pm * 256 * 2048;
            if (pn < 4) { u.B = win + (size_t)pn * 256 * 2048; u.O = qk + ((size_t)pm * 256 * 1024 + pn * 256) * 2; u.ldc = 1024; }
            else { u.B = win + (size_t)(1536 + (pn - 4) * 256) * 2048; u.O = gt + ((size_t)pm * 256 * 1536 + (pn - 4) * 256) * 2; u.ldc = 1536; } }
        else { const int v = L - 640, pmv = v >> 6, pnv = v & 63; u.A = win + (size_t)(1024 + pmv * 256) * 2048; u.B = xb + (size_t)pnv * 256 * 2048;
            u.O = vt + ((size_t)pmv * 256 * SEQ + pnv * 256) * 2; u.ldc = SEQ; }
        return true;
    }
};
struct SchedRes {
    const char *a, *b; char* z; const char* r; int K, G, c;
    __device__ __forceinline__ bool next(int i, Unit& u) const {
        const int L = i * G + c; if (L >= 256) return false;
        const int pm = L >> 2, pn = L & 3;
        u.A = a + (size_t)pm * 256 * K * 2; u.B = b + (size_t)pn * 256 * K * 2; const size_t o = ((size_t)pm * 256 * 1024 + pn * 256) * 4;
        u.O = z + o; u.R = r + o; u.ldc = 1024; u.aux = 0; return true;
    }
};
struct SchedG3 {
    const char *x1b, *wq, *wk, *wv, *memb; char *q2, *kmem, *vmemt; int G, c;
    __device__ __forceinline__ bool next(int i, Unit& u) const {
        const int L = i * G + c; if (L >= 132) return false;
        u.R = nullptr; u.aux = 0;
        if (L < 128) { const int pm = L >> 1, pn = L & 1; u.A = x1b + (size_t)pm * 256 * 2048; u.B = wq + (size_t)pn * 256 * 2048; u.O = q2 + ((size_t)pm * 256 * 512 + pn * 256) * 2; u.ldc = 512; }
        else if (L < 130) { const int pn = L - 128; u.A = memb; u.B = wk + (size_t)pn * 256 * 2048; u.O = kmem + (size_t)pn * 256 * 2; u.ldc = 512; }
        else { const int pm = L - 130; u.A = wv + (size_t)pm * 256 * 2048; u.B = memb; u.O = vmemt + (size_t)pm * 256 * 256 * 2; u.ldc = 256; }
        return true;
    }
};
struct SchedG5 {
    const char *xe, *wgu; char* hid; int G, c;
    __device__ __forceinline__ bool next(int i, Unit& u) const {
        const int L = i * G + c; if (L >= 2048) return false;
        const int e = L >> 7, pm = (L >> 4) & 7, pn = L & 15;
        u.A = xe + (size_t)(e * CAP + pm * 256) * 2048; u.B = wgu + (size_t)(e * 4096 + pn * 256) * 2048;
        u.O = hid + ((size_t)(e * CAP + pm * 256) * FF + pn * 128) * 2; u.R = nullptr; u.ldc = FF; u.aux = 0; return true;
    }
};
struct SchedG6 {
    const char *hid, *wd; char* ye; int G, c;
    __device__ __forceinline__ bool next(int i, Unit& u) const {
        const int L = i * G + c; if (L >= 512) return false;
        const int e = L >> 5, pm = (L >> 2) & 7, pn = L & 3;
        u.A = hid + (size_t)(e * CAP + pm * 256) * 4096; u.B = wd + (size_t)(e * 1024 + pn * 256) * 4096;
        u.O = ye + ((size_t)(e * CAP + pm * 256) * 1024 + pn * 256) * 2; u.R = nullptr; u.ldc = 1024; u.aux = e * CAP + pm * 256; return true;
    }
};

__device__ __forceinline__ void tr_item(const float* __restrict__ src, int ldsrc, int k0, int n0, bf16_t* __restrict__ dst_row0, int lddst, LAS float* scr, int lane) {
    const int g = lane >> 4, l15 = lane & 15;
#pragma unroll 4
    for (int i = 0; i < 16; ++i) {
        const int k = 4 * i + g;
        const f32x4 v = *(const f32x4*)(src + (size_t)(k0 + k) * ldsrc + n0 + 4 * l15);
        LAS float* p = scr + k * 65 + 4 * l15;
        p[0] = v[0]; p[1] = v[1]; p[2] = v[2]; p[3] = v[3];
    }
    asm volatile("s_waitcnt lgkmcnt(0)" ::: "memory");
    const int c = lane & 7;
#pragma unroll
    for (int jj = 0; jj < 8; ++jj) {
        const int n = (lane >> 3) + 8 * jj;
        const LAS float* s = scr + (8 * c) * 65 + n;
        u32x4 o; o.x = pk2(s[0], s[65]); o.y = pk2(s[130], s[195]); o.z = pk2(s[260], s[325]); o.w = pk2(s[390], s[455]);
        *(u32x4*)(dst_row0 + (size_t)n * lddst + k0 + 8 * c) = o;
    }
    asm volatile("s_waitcnt lgkmcnt(0)" ::: "memory");
}
__device__ __forceinline__ void tr_matrix_item(const float* W, int K, int N, bf16_t* WT, int item, LAS float* scr, int lane) {
    const int nb = N / 64, kb = item / nb, n0 = (item % nb) * 64;
    tr_item(W, N, kb * 64, n0, WT + (size_t)n0 * K, K, scr, lane);
}
__device__ __forceinline__ void phase_convert(const Params& p, LAS unsigned char* lds, int gw, int NGW, int gtid, int NT, int wave, int lane) {
    unsigned char* ws = p.ws;
    LAS float* scr = (LAS float*)(lds + wave * 16640);
    constexpr int I_WIN = 16 * 48, I_WOUT = 256, I_WQ = 128, I_WMO = 128, I_EG = 8192, I_ED = 8192;
    constexpr int NITEMS = I_WIN + I_WOUT + 3 * I_WQ + I_WMO + 2 * I_EG + I_ED;
    for (int it = gw; it < NITEMS; it += NGW) {
        int r = it;
        if (r < I_WIN) { tr_matrix_item(p.w_in, 1024, 3072, (bf16_t*)(ws + OFF_WIN), r, scr, lane); continue; } r -= I_WIN;
        if (r < I_WOUT) { tr_matrix_item(p.w_out, 1024, 1024, (bf16_t*)(ws + OFF_WOUT), r, scr, lane); continue; } r -= I_WOUT;
        if (r < I_WQ) { tr_matrix_item(p.wq, 1024, 512, (bf16_t*)(ws + OFF_WQ), r, scr, lane); continue; } r -= I_WQ;
        if (r < I_WQ) { tr_matrix_item(p.wk, 1024, 512, (bf16_t*)(ws + OFF_WK), r, scr, lane); continue; } r -= I_WQ;
        if (r < I_WQ) { tr_matrix_item(p.wv, 1024, 512, (bf16_t*)(ws + OFF_WV), r, scr, lane); continue; } r -= I_WQ;
        if (r < I_WMO) { tr_matrix_item(p.wmo, 512, 1024, (bf16_t*)(ws + OFF_WMO), r, scr, lane); continue; } r -= I_WMO;
        if (r < 2 * I_EG) {
            const int up = r >= I_EG; if (up) r -= I_EG;
            const int e = r >> 9, q = r & 511, kb = q >> 5, n0 = (q & 31) * 64;
            const float* src = (up ? p.weu : p.weg) + (size_t)e * 1024 * 2048;
            bf16_t* dst = (bf16_t*)(ws + OFF_WGU) + ((size_t)e * 4096 + (n0 >> 7) * 256 + (n0 & 127) + (up ? 128 : 0)) * 1024;
            tr_item(src, 2048, kb * 64, n0, dst, 1024, scr, lane); continue;
        }
        r -= 2 * I_EG;
        { const int e = r >> 9, q = r & 511;
          tr_matrix_item(p.wed + (size_t)e * 2048 * 1024, 2048, 1024, (bf16_t*)(ws + OFF_WD) + (size_t)e * 1024 * 2048, q, scr, lane); }
    }
    constexpr int NX = SEQ * DM / 8, NM = MEMLEN * DM / 8;
    for (int it = gtid; it < NX + NM; it += NT) {
        const float* s; bf16_t* d;
        if (it < NX) { s = p.x + (size_t)it * 8; d = (bf16_t*)(ws + OFF_XB) + (size_t)it * 8; }
        else { s = p.mem + (size_t)(it - NX) * 8; d = (bf16_t*)(ws + OFF_MEMB) + (size_t)(it - NX) * 8; }
        const f32x4 a = *(const f32x4*)s, b = *(const f32x4*)(s + 4);
        u32x4 o; o.x = pk2(a[0], a[1]); o.y = pk2(a[2], a[3]); o.z = pk2(b[0], b[1]); o.w = pk2(b[2], b[3]);
        *(u32x4*)d = o;
    }
}

template <int DH, bool IS_NA>
__device__ __forceinline__ void attn_unit(const bf16_t* __restrict__ Qrow, const bf16_t* __restrict__ Kmat, int kld, const bf16_t* __restrict__ VT, int vld,
                                          int key0, int kstride, bf16_t* __restrict__ Orow, float scale, int lane,
                                          const LAS float* rpbh, int dr0, int qc, int cb) {
    constexpr int KS = DH / 32, MT = DH / 16;
    const int i = lane & 15, g = lane >> 4;
    bf16x8 qf[KS];
#pragma unroll
    for (int s = 0; s < KS; ++s) qf[s] = *(const bf16x8*)(Qrow + 32 * s + 8 * g);
    f32x4 sc[8][2];
    const int krow = 8 * (i >> 2) + (i & 3);
    bf16x8 kf[2][2][KS];
    const char* kb = (const char*)Kmat;
    const unsigned klane = (unsigned)((key0 + krow) * kld + 8 * g) * 2u;
    { unsigned kl = klane; asm volatile("" : "+v"(kl));
#pragma unroll
      for (int t = 0; t < 2; ++t)
#pragma unroll
        for (int s = 0; s < KS; ++s) kf[0][t][s] = *(const bf16x8*)(kb + (kl + (unsigned)((4 * t) * kld + 32 * s) * 2u)); }
#pragma unroll
    for (int j = 0; j < 8; ++j) {
        if (j < 7) {
            unsigned kl = klane; asm volatile("" : "+v"(kl));
#pragma unroll
            for (int t = 0; t < 2; ++t)
#pragma unroll
                for (int s = 0; s < KS; ++s) kf[(j + 1) & 1][t][s] = *(const bf16x8*)(kb + (kl + (unsigned)(((j + 1) * kstride + 4 * t) * kld + 32 * s) * 2u));
        }
#pragma unroll
        for (int t = 0; t < 2; ++t) {
            f32x4 a = {0.f, 0.f, 0.f, 0.f};
#pragma unroll
            for (int s = 0; s < KS; ++s) a = __builtin_amdgcn_mfma_f32_16x16x32_bf16(kf[j & 1][t][s], qf[s], a, 0, 0, 0);
            sc[j][t] = a;
        }
        __builtin_amdgcn_sched_barrier(0);
    }
    const int cs = min(max(qc - 8, 0), 48);
    float mx = -1e30f;
#pragma unroll
    for (int j = 0; j < 8; ++j)
#pragma unroll
        for (int t = 0; t < 2; ++t)
#pragma unroll
            for (int jj = 0; jj < 4; ++jj) {
                float v = sc[j][t][jj] * scale;
                if (IS_NA) {
                    const int kc = cb + 8 * g + 4 * t + jj;
                    const bool valid = (kc >= cs) && (kc < cs + 16);
                    const int dc = min(max(kc - qc + 15, 0), 30);
                    v += rpbh[(dr0 + j) * 31 + dc];
                    v = valid ? v : -1e30f;
                }
                sc[j][t][jj] = v; mx = fmaxf(mx, v);
            }
    mx = fmaxf(mx, __shfl_xor(mx, 16)); mx = fmaxf(mx, __shfl_xor(mx, 32));
    float l = 0.f;
#pragma unroll
    for (int j = 0; j < 8; ++j)
#pragma unroll
        for (int t = 0; t < 2; ++t)
#pragma unroll
            for (int jj = 0; jj < 4; ++jj) { const float pv = __expf(sc[j][t][jj] - mx); sc[j][t][jj] = pv; l += pv; }
    l += __shfl_xor(l, 16); l += __shfl_xor(l, 32);
    f32x4 o[MT];
#pragma unroll
    for (int mt = 0; mt < MT; ++mt) o[mt] = (f32x4){0.f, 0.f, 0.f, 0.f};
    bf16x8 vf[2][MT];
    const char* vb = (const char*)VT;
    const unsigned vlane = (unsigned)(i * vld + key0 + 8 * g) * 2u;
    { unsigned vl = vlane; asm volatile("" : "+v"(vl));
#pragma unroll
      for (int mt = 0; mt < MT; ++mt) vf[0][mt] = *(const bf16x8*)(vb + (vl + (unsigned)(16 * mt * vld) * 2u)); }
#pragma unroll
    for (int j = 0; j < 8; ++j) {
        if (j < 7) {
            unsigned vl = vlane; asm volatile("" : "+v"(vl));
#pragma unroll
            for (int mt = 0; mt < MT; ++mt) vf[(j + 1) & 1][mt] = *(const bf16x8*)(vb + (vl + (unsigned)(16 * mt * vld + (j + 1) * kstride) * 2u));
        }
        u32x4 pw; pw.x = pk2(sc[j][0][0], sc[j][0][1]); pw.y = pk2(sc[j][0][2], sc[j][0][3]); pw.z = pk2(sc[j][1][0], sc[j][1][1]); pw.w = pk2(sc[j][1][2], sc[j][1][3]);
        const bf16x8 pf = __builtin_bit_cast(bf16x8, pw);
#pragma unroll
        for (int mt = 0; mt < MT; ++mt) o[mt] = __builtin_amdgcn_mfma_f32_16x16x32_bf16(vf[j & 1][mt], pf, o[mt], 0, 0, 0);
        __builtin_amdgcn_sched_barrier(0);
    }
    const float inv = 1.f / l;
#pragma unroll
    for (int mt = 0; mt < MT; ++mt) {
        u32x2 w; w.x = pk2(o[mt][0] * inv, o[mt][1] * inv); w.y = pk2(o[mt][2] * inv, o[mt][3] * inv);
        *(u32x2*)(Orow + 16 * mt + 4 * g) = w;
    }
}

__device__ __forceinline__ void phase_mixer(const Params& p, LAS unsigned char* lds, int gw, int NGW, int gtid, int NT, int lane) {
    unsigned char* ws = p.ws;
    LAS float* rpbl = (LAS float*)lds;
    for (int i = threadIdx.x; i < 8 * 15 * 31; i += blockDim.x) rpbl[i] = p.rpb[i];
    __syncthreads();
    const bf16_t* QK = (const bf16_t*)(ws + OFF_QK); const bf16_t* VT = (const bf16_t*)(ws + OFF_VT); const bf16_t* GT = (const bf16_t*)(ws + OFF_GT);
    bf16_t* Y = (bf16_t*)(ws + OFF_Y);
    for (int u = gw; u < (SEQ / 16) * 8; u += NGW) {
        const int tb = u >> 3, h = u & 7, r = tb >> 2, qb = tb & 3;
        const int wr0 = min(max(r - 4, 0), 248);
        const int cb = (qb == 0) ? 0 : (qb == 1) ? 8 : (qb == 2) ? 24 : 32;
        const int qc = qb * 16 + (lane & 15), tq = r * 64 + qc;
        attn_unit<64, true>(QK + (size_t)tq * 1024 + h * 64, QK + 512 + h * 64, 1024, VT + (size_t)h * 64 * SEQ, SEQ, wr0 * 64 + cb, 64,
                            Y + (size_t)tq * 1024 + h * 64, 0.125f, lane, rpbl + h * 465, wr0 - r + 7, qc, cb);
    }
    for (int it = gtid; it < SEQ * 64; it += NT) {
        const int t = it >> 6, c8 = (it & 63) * 8;
        float accv[8];
#pragma unroll
        for (int e = 0; e < 8; ++e) accv[e] = 0.f;
#pragma unroll
        for (int dt = 0; dt < 3; ++dt) {
            const int tt = t + dt - 1;
            if (tt >= 0 && tt < SEQ) {
                const u32x4 cg4 = *(const u32x4*)(GT + (size_t)tt * 1536 + 512 + c8), h4 = *(const u32x4*)(GT + (size_t)tt * 1536 + 1024 + c8);
                const f32x4 w0 = *(const f32x4*)(p.conv_w + dt * 512 + c8), w1 = *(const f32x4*)(p.conv_w + dt * 512 + c8 + 4);
                accv[0] += w0[0] * bflo(cg4.x) * bflo(h4.x); accv[1] += w0[1] * bfhi(cg4.x) * bfhi(h4.x);
                accv[2] += w0[2] * bflo(cg4.y) * bflo(h4.y); accv[3] += w0[3] * bfhi(cg4.y) * bfhi(h4.y);
                accv[4] += w1[0] * bflo(cg4.z) * bflo(h4.z); accv[5] += w1[1] * bfhi(cg4.z) * bfhi(h4.z);
                accv[6] += w1[2] * bflo(cg4.w) * bflo(h4.w); accv[7] += w1[3] * bfhi(cg4.w) * bfhi(h4.w);
            }
        }
        const u32x4 b4 = *(const u32x4*)(GT + (size_t)t * 1536 + c8);
        u32x4 o;
        o.x = pk2(accv[0] * bflo(b4.x), accv[1] * bfhi(b4.x)); o.y = pk2(accv[2] * bflo(b4.y), accv[3] * bfhi(b4.y));
        o.z = pk2(accv[4] * bflo(b4.z), accv[5] * bfhi(b4.z)); o.w = pk2(accv[6] * bflo(b4.w), accv[7] * bfhi(b4.w));
        *(u32x4*)(Y + (size_t)t * 1024 + 512 + c8) = o;
    }
}

__device__ __forceinline__ void phase_xattn(const Params& p, int gw, int NGW, int lane) {
    unsigned char* ws = p.ws;
    const bf16_t* Q2 = (const bf16_t*)(ws + OFF_Q2); const bf16_t* KM = (const bf16_t*)(ws + OFF_KMEM); const bf16_t* VM = (const bf16_t*)(ws + OFF_VMEMT);
    bf16_t* O = (bf16_t*)(ws + OFF_O);
    for (int u = gw; u < (SEQ / 16) * 4; u += NGW) {
        const int tb = u >> 2, h = u & 3, tq = tb * 16 + (lane & 15);
        attn_unit<128, false>(Q2 + (size_t)tq * 512 + h * 128, KM + h * 128, 512, VM + (size_t)h * 128 * 256, 256, 0, 32,
                              O + (size_t)tq * 512 + h * 128, 0.08838834764831845f, lane, nullptr, 0, 0, 0);
    }
}

__device__ __forceinline__ void ln_row(f32x4 (&v)[4], const float* __restrict__ gm, const float* __restrict__ bt, int lane) {
    float s = 0.f;
#pragma unroll
    for (int j = 0; j < 4; ++j) s += (v[j][0] + v[j][1]) + (v[j][2] + v[j][3]);
    const float mean = wave_sum(s) * (1.f / DM);
    float s2 = 0.f;
#pragma unroll
    for (int j = 0; j < 4; ++j) { v[j] = v[j] - mean; s2 += (v[j][0] * v[j][0] + v[j][1] * v[j][1]) + (v[j][2] * v[j][2] + v[j][3] * v[j][3]); }
    const float rstd = 1.f / sqrtf(wave_sum(s2) * (1.f / DM) + LNEPS);
#pragma unroll
    for (int j = 0; j < 4; ++j) {
        const f32x4 g4 = *(const f32x4*)(gm + 4 * lane + 256 * j), b4 = *(const f32x4*)(bt + 4 * lane + 256 * j);
        v[j] = v[j] * rstd * g4 + b4;
    }
}
__device__ __forceinline__ void store_row_bf16(bf16_t* row, const f32x4 (&v)[4], int lane) {
#pragma unroll
    for (int j = 0; j < 4; ++j) { u32x2 w; w.x = pk2(v[j][0], v[j][1]); w.y = pk2(v[j][2], v[j][3]); *(u32x2*)(row + 4 * lane + 256 * j) = w; }
}
__device__ __forceinline__ void phase_ln1(const Params& p, int gw, int NGW, int lane) {
    float* Z = (float*)(p.ws + OFF_RB); bf16_t* XB = (bf16_t*)(p.ws + OFF_XB);
    for (int row = gw; row < SEQ; row += NGW) {
        float* zr = Z + (size_t)row * DM; f32x4 v[4];
#pragma unroll
        for (int j = 0; j < 4; ++j) v[j] = *(const f32x4*)(zr + 4 * lane + 256 * j);
        ln_row(v, p.ln1g, p.ln1b, lane);
#pragma unroll
        for (int j = 0; j < 4; ++j) *(f32x4*)(zr + 4 * lane + 256 * j) = v[j];
        store_row_bf16(XB + (size_t)row * DM, v, lane);
    }
}
__device__ __forceinline__ void phase_ln2_router(const Params& p, LAS unsigned char* lds, int gw, int NGW, int lane) {
    LAS float* wT = (LAS float*)lds;
    for (int i = threadIdx.x; i < DM * NEXP; i += blockDim.x) wT[(i & 15) * DM + (i >> 4)] = p.w_router[i];
    __syncthreads();
    float* Z = p.out; bf16_t* XB = (bf16_t*)(p.ws + OFF_X2B); float* affT = (float*)(p.ws + OFF_AFFT);
    for (int row = gw; row < SEQ; row += NGW) {
        float* zr = Z + (size_t)row * DM; f32x4 v[4];
#pragma unroll
        for (int j = 0; j < 4; ++j) v[j] = *(const f32x4*)(zr + 4 * lane + 256 * j);
        ln_row(v, p.ln2g, p.ln2b, lane);
#pragma unroll
        for (int j = 0; j < 4; ++j) *(f32x4*)(zr + 4 * lane + 256 * j) = v[j];
        store_row_bf16(XB + (size_t)row * DM, v, lane);
        float lg[NEXP];
#pragma unroll
        for (int e = 0; e < NEXP; ++e) {
            float a = 0.f;
#pragma unroll
            for (int j = 0; j < 4; ++j) { const f32x4 w = *(const LAS f32x4*)(wT + e * DM + 4 * lane + 256 * j); a += (v[j][0] * w[0] + v[j][1] * w[1]) + (v[j][2] * w[2] + v[j][3] * w[3]); }
            lg[e] = wave_sum(a);
            __builtin_amdgcn_sched_barrier(0);
        }
        float mx = lg[0];
#pragma unroll
        for (int e = 1; e < NEXP; ++e) mx = fmaxf(mx, lg[e]);
        float sum = 0.f;
#pragma unroll
        for (int e = 0; e < NEXP; ++e) { lg[e] = expf(lg[e] - mx); sum += lg[e]; }
        float mine = 0.f;
#pragma unroll
        for (int e = 0; e < NEXP; ++e) mine = (lane == e) ? lg[e] : mine;
        if (lane < NEXP) affT[(size_t)lane * SEQ + row] = mine / sum;
    }
}
__device__ __forceinline__ void phase_final(const Params& p, int gw, int NGW, int lane) {
    float* Z = p.out; const bf16_t* YE = (const bf16_t*)(p.ws + OFF_RB); const int* inv = (const int*)(p.ws + OFF_INV);
    for (int row = gw; row < SEQ; row += NGW) {
        float* zr = Z + (size_t)row * DM; f32x4 v[4];
#pragma unroll
        for (int j = 0; j < 4; ++j) v[j] = *(const f32x4*)(zr + 4 * lane + 256 * j) * ALPHA;
        const int myinv = (lane < NEXP) ? inv[(size_t)row * NEXP + lane] : -1;
#pragma unroll
        for (int e = 0; e < NEXP; ++e) {
            const int slot = __builtin_amdgcn_readlane(myinv, e);
            if (slot >= 0) {
                const bf16_t* yr = YE + (size_t)(e * CAP + slot) * DM;
#pragma unroll
                for (int j = 0; j < 4; ++j) { const u32x2 w = *(const u32x2*)(yr + 4 * lane + 256 * j); v[j][0] += bflo(w.x); v[j][1] += bfhi(w.x); v[j][2] += bflo(w.y); v[j][3] += bfhi(w.y); }
            }
        }
        ln_row(v, p.ln3g, p.ln3b, lane);
#pragma unroll
        for (int j = 0; j < 4; ++j) *(f32x4*)(zr + 4 * lane + 256 * j) = v[j];
    }
}

__device__ __forceinline__ int block_excl_scan(int v, LAS int* tmp, int tid) {
    const int lane = tid & 63, wave = tid >> 6;
    int incl = v;
#pragma unroll
    for (int o = 1; o < 64; o <<= 1) { const int t = __shfl_up(incl, o); if (lane >= o) incl += t; }
    __syncthreads();
    if (lane == 63) tmp[wave] = incl;
    __syncthreads();
    int base = 0;
#pragma unroll
    for (int w = 0; w < 8; ++w) base += (w < wave) ? tmp[w] : 0;
    return base + incl - v;
}
__device__ __forceinline__ void phase_topk(const Params& p, LAS unsigned char* lds, int e) {
    const int tid = threadIdx.x, lane = tid & 63, wave = tid >> 6;
    LAS unsigned* hist = (LAS unsigned*)lds; LAS unsigned* ctl = hist + 256; LAS int* tmp = (LAS int*)(hist + 272);
    LAS unsigned* vals = hist + 320;
    const unsigned* affT = (const unsigned*)(p.ws + OFF_AFFT) + (size_t)e * SEQ;
    int* idx = (int*)(p.ws + OFF_IDX); float* gate = (float*)(p.ws + OFF_GATE); int* inv = (int*)(p.ws + OFF_INV);
#pragma unroll 4
    for (int k = 0; k < 32; ++k) { const int t = k * 512 + tid; vals[t + (t >> 5)] = affT[t]; }
    __syncthreads();
    const LAS unsigned* mine = vals + tid * 33;
    unsigned prefix = 0, need = CAP;
#pragma unroll 1
    for (int ps = 3; ps >= 0; --ps) {
        const int shift = 8 * ps;
        const unsigned maskhi = (ps == 3) ? 0u : (0xFFFFFFFFu << (shift + 8));
        if (tid < 256) hist[tid] = 0;
        __syncthreads();
#pragma unroll 4
        for (int i = 0; i < 32; ++i) { const unsigned x = mine[i]; if ((x & maskhi) == prefix) __hip_atomic_fetch_add(&hist[(x >> shift) & 255], 1u, __ATOMIC_RELAXED, __HIP_MEMORY_SCOPE_WORKGROUP); }
        __syncthreads();
        if (wave == 0) {
            const unsigned c0 = hist[255 - 4 * lane], c1 = hist[254 - 4 * lane], c2 = hist[253 - 4 * lane], c3 = hist[252 - 4 * lane];
            const unsigned s = c0 + c1 + c2 + c3;
            unsigned incl = s;
#pragma unroll
            for (int o = 1; o < 64; o <<= 1) { const unsigned t = __shfl_up(incl, o); if (lane >= o) incl += t; }
            const unsigned excl = incl - s;
            if (excl < need && need <= incl) {
                unsigned rem = need - excl; int bin;
                if (rem <= c0) bin = 255 - 4 * lane;
                else { rem -= c0; if (rem <= c1) bin = 254 - 4 * lane; else { rem -= c1; if (rem <= c2) bin = 253 - 4 * lane; else { rem -= c2; bin = 252 - 4 * lane; } } }
                ctl[0] = prefix | ((unsigned)bin << shift); ctl[1] = rem;
            }
        }
        __syncthreads();
        prefix = ctl[0]; need = ctl[1];
        __syncthreads();
    }
    const unsigned T = prefix;
    int ngt = 0, neq = 0;
#pragma unroll 4
    for (int i = 0; i < 32; ++i) { const unsigned x = mine[i]; ngt += (x > T) ? 1 : 0; neq += (x == T) ? 1 : 0; }
    const int eq_before = block_excl_scan(neq, tmp, tid);
    const int take_eq = min(max((int)need - eq_before, 0), neq);
    const int sel_before = block_excl_scan(ngt + take_eq, tmp, tid);
    int slot = sel_before, eqr = eq_before;
#pragma unroll 2
    for (int i = 0; i < 32; ++i) {
        const int t = tid * 32 + i;
        const unsigned x = mine[i];
        const bool iseq = (x == T);
        const bool sl = (x > T) || (iseq && eqr < (int)need);
        eqr += iseq ? 1 : 0;
        if (sl) { idx[e * CAP + slot] = t; gate[e * CAP + slot] = __uint_as_float(x); ++slot; }
        inv[(size_t)t * NEXP + e] = sl ? (slot - 1) : -1;
    }
}
__device__ __forceinline__ void phase_gather(const Params& p, int gw, int NGW, int lane) {
    const bf16_t* XB = (const bf16_t*)(p.ws + OFF_X2B); bf16_t* XE = (bf16_t*)(p.ws + OFF_RB); const int* idx = (const int*)(p.ws + OFF_IDX);
    for (int row = gw; row < NEXP * CAP; row += NGW) {
        const int t = idx[row];
        const u32x4* s = (const u32x4*)(XB + (size_t)t * DM); u32x4* d = (u32x4*)(XE + (size_t)row * DM);
        const u32x4 a = s[lane], b = s[64 + lane];
        d[lane] = a; d[64 + lane] = b;
    }
}

#ifndef PHMASK
#define PHMASK 0xFFFF
#endif
#define PH(n) if ((PHMASK >> (n)) & 1)
__global__ void __launch_bounds__(512, 2) fwd_megakernel(Params p) {
    extern __shared__ __attribute__((aligned(16))) unsigned char shm[];
    LAS unsigned char* lds = (LAS unsigned char*)shm;
    cg::grid_group grid = cg::this_grid();
    const int tid = threadIdx.x, lane = tid & 63, wave = __builtin_amdgcn_readfirstlane(tid >> 6);
    const int G = gridDim.x, c = blockIdx.x;
    const int gw = c * 8 + wave, NGW = G * 8, gtid = c * 512 + tid, NT = G * 512;
    unsigned char* ws = p.ws;

    PH(0) phase_convert(p, lds, gw, NGW, gtid, NT, wave, lane);
    grid.sync();
    PH(1) { SchedG1 S{(const char*)(ws + OFF_XB), (const char*)(ws + OFF_WIN), (char*)(ws + OFF_QK), (char*)(ws + OFF_VT), (char*)(ws + OFF_GT), G, c};
      pg8::gemm_phase(lds, 1024, S, pg8::EpiBf16{}); }
    grid.sync();
    PH(2) phase_mixer(p, lds, gw, NGW, gtid, NT, lane);
    grid.sync();
    PH(3) { SchedRes S{(const char*)(ws + OFF_Y), (const char*)(ws + OFF_WOUT), (char*)(ws + OFF_RB), (const char*)p.x, 1024, G, c};
      pg8::gemm_phase(lds, 1024, S, pg8::EpiRes{}); }
    grid.sync();
    PH(4) phase_ln1(p, gw, NGW, lane);
    grid.sync();
    PH(5) { SchedG3 S{(const char*)(ws + OFF_XB), (const char*)(ws + OFF_WQ), (const char*)(ws + OFF_WK), (const char*)(ws + OFF_WV), (const char*)(ws + OFF_MEMB),
                (char*)(ws + OFF_Q2), (char*)(ws + OFF_KMEM), (char*)(ws + OFF_VMEMT), G, c};
      pg8::gemm_phase(lds, 1024, S, pg8::EpiBf16{}); }
    grid.sync();
    PH(6) phase_xattn(p, gw, NGW, lane);
    grid.sync();
    PH(7) { SchedRes S{(const char*)(ws + OFF_O), (const char*)(ws + OFF_WMO), (char*)p.out, (const char*)(ws + OFF_RB), 512, G, c};
      pg8::gemm_phase(lds, 512, S, pg8::EpiRes{}); }
    grid.sync();
    PH(8) phase_ln2_router(p, lds, gw, NGW, lane);
    grid.sync();
    PH(9) if (c < NEXP) phase_topk(p, lds, c);
    grid.sync();
    PH(10) phase_gather(p, gw, NGW, lane);
    grid.sync();
    PH(11) { SchedG5 S{(const char*)(ws + OFF_RB), (const char*)(ws + OFF_WGU), (char*)(ws + OFF_HID), G, c};
      pg8::gemm_phase(lds, 1024, S, pg8::EpiSwiGLU{}); }
    grid.sync();
    PH(12) { SchedG6 S{(const char*)(ws + OFF_HID), (const char*)(ws + OFF_WD), (char*)(ws + OFF_RB), G, c};
      pg8::gemm_phase(lds, 2048, S, pg8::EpiGate{(const float*)(ws + OFF_GATE)}); }
    grid.sync();
    PH(13) phase_final(p, gw, NGW, lane);
}

extern "C" void kernel_launch(void* const* d_in, const int* in_sizes, int n_in, void* d_out, int out_size, void* d_ws, size_t ws_size, hipStream_t stream) {
    static int grid_blocks = 0;
    if (grid_blocks == 0) {
        if (n_in != 20 || out_size != SEQ * DM || ws_size < WS_END) { fprintf(stderr, "kernel_launch: unexpected shapes (n_in %d, out %d, ws %zu)\n", n_in, out_size, ws_size); grid_blocks = -1; return; }
        int dev = 0, cus = 0, per_cu = 0;
        hipGetDevice(&dev);
        hipDeviceGetAttribute(&cus, hipDeviceAttributeMultiprocessorCount, dev);
        if (hipFuncSetAttribute((const void*)fwd_megakernel, hipFuncAttributeMaxDynamicSharedMemorySize, LDS_BYTES) != hipSuccess) { fprintf(stderr, "kernel_launch: hipFuncSetAttribute failed\n"); grid_blocks = -1; return; }
        if (hipOccupancyMaxActiveBlocksPerMultiprocessor(&per_cu, (const void*)fwd_megakernel, 512, LDS_BYTES) != hipSuccess || per_cu < 1) per_cu = 1;
        (void)hipGetLastError();
        grid_blocks = cus * per_cu;
    }
    if (grid_blocks < 0) return;
    Params p{};
    const float** f = (const float**)&p;
    for (int i = 0; i < 20; ++i) f[i] = (const float*)d_in[i];
    p.out = (float*)d_out; p.ws = (unsigned char*)d_ws;
    void* args[] = {&p};
    hipError_t e = hipLaunchCooperativeKernel((const void*)fwd_megakernel, dim3(grid_blocks), dim3(512), args, LDS_BYTES, stream);
    if (e != hipSuccess) fprintf(stderr, "cooperative launch failed: %s (grid %d)\n", hipGetErrorString(e), grid_blocks);
}
```

```cpp
#include <hip/hip_runtime.h>
#include <hip/hip_cooperative_groups.h>
#include <cstdio>
#include <cstdint>
namespace cg = cooperative_groups;

#define LAS __attribute__((address_space(3)))
typedef unsigned short bf16_t;
typedef short bf16x8 __attribute__((ext_vector_type(8)));
typedef float f32x4 __attribute__((ext_vector_type(4)));
typedef float f32x2 __attribute__((ext_vector_type(2)));
typedef unsigned u32x4 __attribute__((ext_vector_type(4)));
typedef unsigned u32x2 __attribute__((ext_vector_type(2)));
typedef __bf16 bfv2 __attribute__((ext_vector_type(2)));

constexpr int SEQ = 16384, DM = 1024, MEMLEN = 256, NEXP = 16, CAP = 2048, FF = 2048;
constexpr float ALPHA = 1.189207115002721f;
constexpr float LNEPS = 1e-5f;
constexpr size_t MiB = 1u << 20;
constexpr size_t OFF_WIN = 0, OFF_WOUT = 6 * MiB, OFF_WQ = 8 * MiB, OFF_WK = 9 * MiB, OFF_WV = 10 * MiB, OFF_WMO = 11 * MiB,
                 OFF_MEMB = 12 * MiB, OFF_KMEM = 12 * MiB + 512 * 1024, OFF_VMEMT = 12 * MiB + 768 * 1024,
                 OFF_AFFT = 13 * MiB, OFF_INV = 14 * MiB, OFF_IDX = 15 * MiB, OFF_GATE = 15 * MiB + 128 * 1024, OFF_CTL = 15 * MiB + 256 * 1024,
                 OFF_WGU = 16 * MiB, OFF_WD = 144 * MiB,
                 OFF_RA = 208 * MiB, OFF_QK = OFF_RA, OFF_VT = 240 * MiB, OFF_GT = 256 * MiB, OFF_Y = 304 * MiB, OFF_HID = OFF_RA,
                 OFF_RB = 336 * MiB,
                 OFF_XB = 400 * MiB,
                 OFF_Q2 = 432 * MiB, OFF_O = 448 * MiB, OFF_X2B = OFF_Q2,
                 WS_END = 464 * MiB;
constexpr int LDS_BYTES = 136 * 1024;

struct Params {
    const float *x, *mem, *w_in, *rpb, *conv_w, *w_out, *ln1g, *ln1b, *wq, *wk, *wv, *wmo, *ln2g, *ln2b, *w_router, *weg, *weu, *wed, *ln3g, *ln3b;
    float* out; unsigned char* ws;
};

__device__ __forceinline__ unsigned pk2(float a, float b) { f32x2 f = {a, b}; bfv2 r = __builtin_convertvector(f, bfv2); return __builtin_bit_cast(unsigned, r); }
__device__ __forceinline__ float bflo(unsigned w) { return __uint_as_float(w << 16); }
__device__ __forceinline__ float bfhi(unsigned w) { return __uint_as_float(w & 0xffff0000u); }
__device__ __forceinline__ float wave_sum(float v) {
#pragma unroll
    for (int o = 1; o < 64; o <<= 1) v += __shfl_xor(v, o);
    return v;
}

namespace pg8 {
constexpr int BM = 256, BK = 64, HALF = 128, HTB = HALF * BK * 2, STAGE_BYTES = 8 * HTB;
__device__ __forceinline__ int lds_byte(int r, int c) { const int st = (r >> 4) * 2 + (c >> 5), rr = r & 15, cc = c & 31, ob = rr * 64 + cc * 2; return st * 1024 + (ob ^ (((ob >> 9) & 1) << 5)); }
__device__ __forceinline__ void stage_rc(int b, int& R, int& C) { const int st = b / 1024, sb = b % 1024, swz = sb ^ (((sb >> 9) & 1) << 5); R = (st >> 1) * 16 + swz / 64; C = (st & 1) * 32 + (swz % 64) / 2; }
__device__ __forceinline__ int perm32(int rho) { const int n = rho >> 4, i = rho & 15; return 8 * (i >> 2) + 4 * n + (i & 3); }

struct Unit { const char* A; const char* B; char* O; const char* R; int ldc; int aux; };

struct EpiBf16 {
    static constexpr bool PERM = true;
    __device__ __forceinline__ void operator()(const f32x4 (&acc)[2][2][4][2], const Unit& u, int wr, int wc, int fr, int fq) const {
        bf16_t* O = (bf16_t*)u.O;
#pragma unroll
        for (int ai = 0; ai < 2; ++ai)
#pragma unroll
            for (int m = 0; m < 4; ++m) {
                bf16_t* rowp = O + (size_t)(ai * 128 + wr * 64 + m * 16 + fr) * u.ldc + wc * 32 + 8 * fq;
#pragma unroll
                for (int bj = 0; bj < 2; ++bj) {
                    const f32x4 a0 = acc[ai][bj][m][0], a1 = acc[ai][bj][m][1];
                    u32x4 o; o.x = pk2(a0[0], a0[1]); o.y = pk2(a0[2], a0[3]); o.z = pk2(a1[0], a1[1]); o.w = pk2(a1[2], a1[3]);
                    *(u32x4*)(rowp + bj * 128) = o;
                }
            }
    }
};
struct EpiGate {
    static constexpr bool PERM = true;
    const float* gate;
    __device__ __forceinline__ void operator()(const f32x4 (&acc)[2][2][4][2], const Unit& u, int wr, int wc, int fr, int fq) const {
        bf16_t* O = (bf16_t*)u.O;
#pragma unroll
        for (int ai = 0; ai < 2; ++ai)
#pragma unroll
            for (int m = 0; m < 4; ++m) {
                const int row = ai * 128 + wr * 64 + m * 16 + fr;
                const float gt = gate[u.aux + row];
                bf16_t* rowp = O + (size_t)row * u.ldc + wc * 32 + 8 * fq;
#pragma unroll
                for (int bj = 0; bj < 2; ++bj) {
                    const f32x4 a0 = acc[ai][bj][m][0] * gt, a1 = acc[ai][bj][m][1] * gt;
                    u32x4 o; o.x = pk2(a0[0], a0[1]); o.y = pk2(a0[2], a0[3]); o.z = pk2(a1[0], a1[1]); o.w = pk2(a1[2], a1[3]);
                    *(u32x4*)(rowp + bj * 128) = o;
                }
            }
    }
};
struct EpiRes {
    static constexpr bool PERM = false;
    __device__ __forceinline__ void operator()(const f32x4 (&acc)[2][2][4][2], const Unit& u, int wr, int wc, int fr, int fq) const {
        float* Z = (float*)u.O; const float* R = (const float*)u.R;
#pragma unroll
        for (int ai = 0; ai < 2; ++ai)
#pragma unroll
            for (int m = 0; m < 4; ++m) {
                const size_t ro = (size_t)(ai * 128 + wr * 64 + m * 16 + fr) * u.ldc + wc * 32 + 4 * fq;
#pragma unroll
                for (int bj = 0; bj < 2; ++bj)
#pragma unroll
                    for (int n = 0; n < 2; ++n) {
                        const f32x4 r = *(const f32x4*)(R + ro + bj * 128 + n * 16);
                        *(f32x4*)(Z + ro + bj * 128 + n * 16) = acc[ai][bj][m][n] + r * ALPHA;
                    }
            }
    }
};
__device__ __forceinline__ float swi(float g, float u) { return g * u / (1.f + __expf(-g)); }
struct EpiSwiGLU {
    static constexpr bool PERM = true;
    __device__ __forceinline__ void operator()(const f32x4 (&acc)[2][2][4][2], const Unit& u, int wr, int wc, int fr, int fq) const {
        bf16_t* O = (bf16_t*)u.O;
#pragma unroll
        for (int ai = 0; ai < 2; ++ai)
#pragma unroll
            for (int m = 0; m < 4; ++m) {
                bf16_t* rowp = O + (size_t)(ai * 128 + wr * 64 + m * 16 + fr) * u.ldc + wc * 32 + 8 * fq;
                const f32x4 g0 = acc[ai][0][m][0], g1 = acc[ai][0][m][1], u0 = acc[ai][1][m][0], u1 = acc[ai][1][m][1];
                u32x4 o;
                o.x = pk2(swi(g0[0], u0[0]), swi(g0[1], u0[1])); o.y = pk2(swi(g0[2], u0[2]), swi(g0[3], u0[3]));
                o.z = pk2(swi(g1[0], u1[0]), swi(g1[1], u1[1])); o.w = pk2(swi(g1[2], u1[2]), swi(g1[3], u1[3]));
                *(u32x4*)rowp = o;
            }
    }
};

template <class Epi, class Sched>
__device__ __forceinline__ void gemm_phase(LAS unsigned char* lds, const int K, const Sched& S, const Epi& E) {
    int tid = threadIdx.x; asm volatile("" : "+v"(tid));
    const int wid = __builtin_amdgcn_readfirstlane(tid >> 6), lane = tid & 63, wr = wid >> 2, wc = wid & 3, fr = lane & 15, fq = lane >> 4;
    const int nt = K / BK;
    unsigned voffA[2], voffB[2];
#pragma unroll
    for (int i = 0; i < 2; ++i) { int R, C; stage_rc(tid * 16 + i * 8192, R, C); const int Rb = Epi::PERM ? ((R & ~31) + perm32(R & 31)) : R;
        voffA[i] = (unsigned)(R * K + C) * 2u; voffB[i] = (unsigned)(Rb * K + C) * 2u; }
    const size_t kstep = (size_t)(BK * 2);
    const size_t hstep = (size_t)HALF * K * 2;
    const unsigned ldsw = (unsigned)wid * 1024u;
    const int aoff = lds_byte(wr * 64 + fr, fq * 8), boff = lds_byte(wc * 32 + fr, fq * 8);
#define PG8_SA(b, h) (((b) * 2 + (h)) * HTB)
#define PG8_SB(b, h) ((4 + (b) * 2 + (h)) * HTB)
#define PG8_STAGE(bufoff, gbase, voff) do { _Pragma("unroll") for (int _i = 0; _i < 2; ++_i) \
        __builtin_amdgcn_global_load_lds((const unsigned*)((const char*)(gbase) + (voff)[_i]), (LAS unsigned*)(lds + (bufoff) + ldsw + _i * 8192), 16, 0, 0); } while (0)
#define PG8_LDA(dst, b, h) do { _Pragma("unroll") for (int m = 0; m < 4; ++m) _Pragma("unroll") for (int k = 0; k < 2; ++k) dst[m][k] = *(const LAS bf16x8*)(lds + PG8_SA(b, h) + aoff + m * 2048 + k * 1024); } while (0)
#define PG8_LDB(dst, b, h) do { _Pragma("unroll") for (int n = 0; n < 2; ++n) _Pragma("unroll") for (int k = 0; k < 2; ++k) dst[n][k] = *(const LAS bf16x8*)(lds + PG8_SB(b, h) + boff + n * 2048 + k * 1024); } while (0)
#define PG8_MMA(ai, bj, At, Bt) do { __builtin_amdgcn_s_setprio(1); _Pragma("unroll") for (int m = 0; m < 4; ++m) _Pragma("unroll") for (int n = 0; n < 2; ++n) _Pragma("unroll") for (int k = 0; k < 2; ++k) \
        acc[ai][bj][m][n] = __builtin_amdgcn_mfma_f32_16x16x32_bf16(Bt[n][k], At[m][k], acc[ai][bj][m][n], 0, 0, 0); __builtin_amdgcn_s_setprio(0); } while (0)
#define PG8_WAIT_V(n) asm volatile("s_waitcnt vmcnt(" #n ")" ::: "memory")
#define PG8_WAIT_L(n) asm volatile("s_waitcnt lgkmcnt(" #n ")" ::: "memory")
#define PG8_BAR __builtin_amdgcn_s_barrier()
#define PG8_SCHED __builtin_amdgcn_sched_barrier(0)
    Unit cur, nxt; int ui = 0;
    if (!S.next(0, cur)) return;
    f32x4 acc[2][2][4][2];
#pragma unroll
    for (int a = 0; a < 2; ++a)
#pragma unroll
        for (int b = 0; b < 2; ++b)
#pragma unroll
            for (int m = 0; m < 4; ++m)
#pragma unroll
                for (int n = 0; n < 2; ++n) acc[a][b][m][n] = (f32x4){0.f, 0.f, 0.f, 0.f};
    bf16x8 At[4][2], B0[2][2], B1[2][2];
    const char* cA = cur.A; const char* cB = cur.B;
    PG8_STAGE(PG8_SB(0, 0), cB, voffB); PG8_STAGE(PG8_SA(0, 0), cA, voffA); PG8_STAGE(PG8_SB(0, 1), cB + hstep, voffB); PG8_STAGE(PG8_SA(0, 1), cA + hstep, voffA);
    if (wr == 1) PG8_BAR;
    PG8_WAIT_V(4); PG8_BAR;
    PG8_STAGE(PG8_SB(1, 0), cB + kstep, voffB); PG8_STAGE(PG8_SA(1, 0), cA + kstep, voffA); PG8_STAGE(PG8_SB(1, 1), cB + hstep + kstep, voffB);
    PG8_WAIT_V(6); PG8_BAR;
    for (;;) {
        const bool has_next = S.next(ui + 1, nxt);
        const char* nA = has_next ? nxt.A : cA; const char* nB = has_next ? nxt.B : cB;
        for (int t = 0; t < nt; t += 2) {
            const bool last = (t == nt - 2);
            const char* a1 = cA + (size_t)(t + 1) * kstep;
            const char* a2 = last ? nA : cA + (size_t)(t + 2) * kstep; const char* b2 = last ? nB : cB + (size_t)(t + 2) * kstep;
            const char* a3 = a2 + kstep; const char* b3 = b2 + kstep;
            PG8_LDB(B0, 0, 0); PG8_SCHED; PG8_LDA(At, 0, 0); PG8_STAGE(PG8_SA(1, 1), a1 + hstep, voffA);
            PG8_WAIT_L(8); PG8_BAR; PG8_WAIT_L(0); PG8_MMA(0, 0, At, B0); PG8_BAR; PG8_SCHED;
            PG8_LDB(B1, 0, 1); PG8_STAGE(PG8_SB(0, 0), b2, voffB);
            PG8_BAR; PG8_WAIT_L(0); PG8_MMA(0, 1, At, B1); PG8_BAR;
            PG8_LDA(At, 0, 1); PG8_STAGE(PG8_SA(0, 0), a2, voffA);
            PG8_BAR; PG8_WAIT_L(0); PG8_MMA(1, 0, At, B0); PG8_BAR; PG8_SCHED;
            PG8_STAGE(PG8_SB(0, 1), b2 + hstep, voffB);
            PG8_WAIT_V(6); PG8_BAR; PG8_MMA(1, 1, At, B1); PG8_BAR;
            PG8_LDB(B0, 1, 0); PG8_SCHED; PG8_LDA(At, 1, 0); PG8_STAGE(PG8_SA(0, 1), a2 + hstep, voffA);
            PG8_WAIT_L(8); PG8_BAR; PG8_WAIT_L(0); PG8_MMA(0, 0, At, B0); PG8_BAR; PG8_SCHED;
            PG8_LDB(B1, 1, 1); PG8_STAGE(PG8_SB(1, 0), b3, voffB);
            PG8_BAR; PG8_WAIT_L(0); PG8_MMA(0, 1, At, B1); PG8_BAR;
            PG8_LDA(At, 1, 1); PG8_STAGE(PG8_SA(1, 0), a3, voffA);
            PG8_BAR; PG8_WAIT_L(0); PG8_MMA(1, 0, At, B0); PG8_BAR; PG8_SCHED;
            PG8_STAGE(PG8_SB(1, 1), b3 + hstep, voffB);
            PG8_WAIT_V(6); PG8_BAR; PG8_MMA(1, 1, At, B1); PG8_BAR;
        }
        E(acc, cur, wr, wc, fr, fq);
        if (!has_next) break;
#pragma unroll
        for (int a = 0; a < 2; ++a)
#pragma unroll
            for (int b = 0; b < 2; ++b)
#pragma unroll
                for (int m = 0; m < 4; ++m)
#pragma unroll
                    for (int n = 0; n < 2; ++n) acc[a][b][m][n] = (f32x4){0.f, 0.f, 0.f, 0.f};
        cur = nxt; cA = nA; cB = nB; ++ui;
    }
    PG8_WAIT_V(0);
    if (wr == 0) PG8_BAR;
    PG8_BAR;
#undef PG8_SA
#undef PG8_SB
#undef PG8_STAGE
#undef PG8_LDA
#undef PG8_LDB
#undef PG8_MMA
#undef PG8_WAIT_V
#undef PG8_WAIT_L
#undef PG8_BAR
#undef PG8_SCHED
}
}
using pg8::Unit;

struct SchedG1 {
    const char *xb, *win; char *qk, *vt, *gt; int G, c;
    __device__ __forceinline__ bool next(int i, Unit& u) const {
        const int L = i * G + c; if (L >= 768) return false;
        u.R = nullptr; u.aux = 0;
        if (L < 640) { const int pm = L / 10, pn = L % 10; u.A = xb + (size_t)pm * 256 * 2048;
            if (pn < 4) { u.B = win + (size_t)pn * 256 * 2048; u.O = qk + ((size_t)pm * 256 * 1024 + pn * 256) * 2; u.ldc = 1024; }
            else { u.B = win + (size_t)(1536 + (pn - 4) * 256) * 2048; u.O = gt + ((size_t)pm * 256 * 1536 + (pn - 4) * 256) * 2; u.ldc = 1536; } }
        else { const int v = L - 640, pmv = v >> 6, pnv = v & 63; u.A = win + (size_t)(1024 + pmv * 256) * 2048; u.B = xb + (size_t)pnv * 256 * 2048;
            u.O = vt + ((size_t)pmv * 256 * SEQ + pnv * 256) * 2; u.ldc = SEQ; }
        return true;
    }
};
struct SchedRes {
    const char *a, *b; char* z; const char* r; int K, G, c;
    __device__ __forceinline__ bool next(int i, Unit& u) const {
        const int L = i * G + c; if (L >= 256) return false;
        const int pm = L >> 2, pn = L & 3;
        u.A = a + (size_t)pm * 256 * K * 2; u.B = b + (size_t)pn * 256 * K * 2; const size_t o = ((size_t)pm * 256 * 1024 + pn * 256) * 4;
        u.O = z + o; u.R = r + o; u.ldc = 1024; u.aux = 0; return true;
    }
};
struct SchedG3 {
    const char *x1b, *wq, *wk, *wv, *memb; char *q2, *kmem, *vmemt; int G, c;
    __device__ __forceinline__ bool next(int i, Unit& u) const {
        const int L = i * G + c; if (L >= 132) return false;
        u.R = nullptr; u.aux = 0;
        if (L < 128) { const int pm = L >> 1, pn = L & 1; u.A = x1b + (size_t)pm * 256 * 2048; u.B = wq + (size_t)pn * 256 * 2048; u.O = q2 + ((size_t)pm * 256 * 512 + pn * 256) * 2; u.ldc = 512; }
        else if (L < 130) { const int pn = L - 128; u.A = memb; u.B = wk + (size_t)pn * 256 * 2048; u.O = kmem + (size_t)pn * 256 * 2; u.ldc = 512; }
        else { const int pm = L - 130; u.A = wv + (size_t)pm * 256 * 2048; u.B = memb; u.O = vmemt + (size_t)pm * 256 * 256 * 2; u.ldc = 256; }
        return true;
    }
};
struct SchedG5 {
    const char *xe, *wgu; char* hid; int G, c;
    __device__ __forceinline__ bool next(int i, Unit& u) const {
        const int L = i * G + c; if (L >= 2048) return false;
        const int e = L >> 7, pm = (L >> 4) & 7, pn = L & 15;
        u.A = xe + (size_t)(e * CAP + pm * 256) * 2048; u.B = wgu + (size_t)(e * 4096 + pn * 256) * 2048;
        u.O = hid + ((size_t)(e * CAP + pm * 256) * FF + pn * 128) * 2; u.R = nullptr; u.ldc = FF; u.aux = 0; return true;
    }
};
struct SchedG6 {
    const char *hid, *wd; char* ye; int G, c;
    __device__ __forceinline__ bool next(int i, Unit& u) const {
        const int L = i * G + c; if (L >= 512) return false;
        const int e = L >> 5, pm = (L >> 2) & 7, pn = L & 3;
        u.A = hid + (size_t)(e * CAP + pm * 256) * 4096; u.B = wd + (size_t)(e * 1024 + pn * 256) * 4096;
        u.O = ye + ((size_t)(e * CAP + pm * 256) * 1024 + pn * 256) * 2; u.R = nullptr; u.ldc = 1024; u.aux = e * CAP + pm * 256; return true;
    }
};

__device__ __forceinline__ void tr_item(const float* __restrict__ src, int ldsrc, int k0, int n0, bf16_t* __restrict__ dst_row0, int lddst, LAS float* scr, int lane) {
    const int g = lane >> 4, l15 = lane & 15;
    f32x4 v[16];
    const float* sp = src + (size_t)(k0 + g) * ldsrc + n0 + 4 * l15;
#pragma unroll
    for (int i = 0; i < 16; ++i) v[i] = __builtin_nontemporal_load((const f32x4*)(sp + (size_t)(4 * i) * ldsrc));
#pragma unroll
    for (int i = 0; i < 16; ++i) {
        LAS float* p = scr + (4 * i + g) * 65 + 4 * l15;
        p[0] = v[i][0]; p[1] = v[i][1]; p[2] = v[i][2]; p[3] = v[i][3];
    }
    asm volatile("s_waitcnt lgkmcnt(0)" ::: "memory");
    const int c = lane & 7;
#pragma unroll
    for (int jj = 0; jj < 8; ++jj) {
        const int n = (lane >> 3) + 8 * jj;
        const LAS float* s = scr + (8 * c) * 65 + n;
        u32x4 o; o.x = pk2(s[0], s[65]); o.y = pk2(s[130], s[195]); o.z = pk2(s[260], s[325]); o.w = pk2(s[390], s[455]);
        *(u32x4*)(dst_row0 + (size_t)n * lddst + k0 + 8 * c) = o;
    }
    asm volatile("s_waitcnt lgkmcnt(0)" ::: "memory");
}
__device__ __forceinline__ void tr_matrix_item(const float* W, int K, int N, bf16_t* WT, int item, LAS float* scr, int lane) {
    const int nb = N / 64, kb = item / nb, n0 = (item % nb) * 64;
    tr_item(W, N, kb * 64, n0, WT + (size_t)n0 * K, K, scr, lane);
}
__device__ __forceinline__ void phase_convert(const Params& p, LAS unsigned char* lds, int gw, int NGW, int gtid, int NT, int wave, int lane) {
    unsigned char* ws = p.ws;
    LAS float* scr = (LAS float*)(lds + wave * 16640);
    constexpr int I_WIN = 16 * 48, I_WOUT = 256, I_WQ = 128, I_WMO = 128, I_EG = 8192, I_ED = 8192;
    constexpr int NITEMS = I_WIN + I_WOUT + 3 * I_WQ + I_WMO + 2 * I_EG + I_ED;
    for (int it = gw; it < NITEMS; it += NGW) {
        int r = it;
        if (r < I_WIN) { tr_matrix_item(p.w_in, 1024, 3072, (bf16_t*)(ws + OFF_WIN), r, scr, lane); continue; } r -= I_WIN;
        if (r < I_WOUT) { tr_matrix_item(p.w_out, 1024, 1024, (bf16_t*)(ws + OFF_WOUT), r, scr, lane); continue; } r -= I_WOUT;
        if (r < I_WQ) { tr_matrix_item(p.wq, 1024, 512, (bf16_t*)(ws + OFF_WQ), r, scr, lane); continue; } r -= I_WQ;
        if (r < I_WQ) { tr_matrix_item(p.wk, 1024, 512, (bf16_t*)(ws + OFF_WK), r, scr, lane); continue; } r -= I_WQ;
        if (r < I_WQ) { tr_matrix_item(p.wv, 1024, 512, (bf16_t*)(ws + OFF_WV), r, scr, lane); continue; } r -= I_WQ;
        if (r < I_WMO) { tr_matrix_item(p.wmo, 512, 1024, (bf16_t*)(ws + OFF_WMO), r, scr, lane); continue; } r -= I_WMO;
        if (r < 2 * I_EG) {
            const int up = r >= I_EG; if (up) r -= I_EG;
            const int e = r >> 9, q = r & 511, kb = q >> 5, n0 = (q & 31) * 64;
            const float* src = (up ? p.weu : p.weg) + (size_t)e * 1024 * 2048;
            bf16_t* dst = (bf16_t*)(ws + OFF_WGU) + ((size_t)e * 4096 + (n0 >> 7) * 256 + (n0 & 127) + (up ? 128 : 0)) * 1024;
            tr_item(src, 2048, kb * 64, n0, dst, 1024, scr, lane); continue;
        }
        r -= 2 * I_EG;
        { const int e = r >> 9, q = r & 511;
          tr_matrix_item(p.wed + (size_t)e * 2048 * 1024, 2048, 1024, (bf16_t*)(ws + OFF_WD) + (size_t)e * 1024 * 2048, q, scr, lane); }
    }
    constexpr int NX = SEQ * DM / 8, NM = MEMLEN * DM / 8;
    for (int it = gtid; it < NX + NM; it += NT) {
        const float* s; bf16_t* d;
        if (it < NX) { s = p.x + (size_t)it * 8; d = (bf16_t*)(ws + OFF_XB) + (size_t)it * 8; }
        else { s = p.mem + (size_t)(it - NX) * 8; d = (bf16_t*)(ws + OFF_MEMB) + (size_t)(it - NX) * 8; }
        const f32x4 a = *(const f32x4*)s, b = *(const f32x4*)(s + 4);
        u32x4 o; o.x = pk2(a[0], a[1]); o.y = pk2(a[2], a[3]); o.z = pk2(b[0], b[1]); o.w = pk2(b[2], b[3]);
        *(u32x4*)d = o;
    }
}

template <int DH, bool IS_NA>
__device__ __forceinline__ void attn_unit(const bf16_t* __restrict__ Qrow, const bf16_t* __restrict__ Kmat, int kld, const bf16_t* __restrict__ VT, int vld,
                                          int key0, int kstride, bf16_t* __restrict__ Orow, float scale, int lane,
                                          const LAS float* rpbh, int dr0, int qc, int cb) {
    constexpr int KS = DH / 32, MT = DH / 16;
    const int i = lane & 15, g = lane >> 4;
    bf16x8 qf[KS];
#pragma unroll
    for (int s = 0; s < KS; ++s) qf[s] = *(const bf16x8*)(Qrow + 32 * s + 8 * g);
    f32x4 sc[8][2];
    const int krow = 8 * (i >> 2) + (i & 3);
    bf16x8 kf[2][2][KS];
    const char* kb = (const char*)Kmat;
    const unsigned klane = (unsigned)((key0 + krow) * kld + 8 * g) * 2u;
    { unsigned kl = klane; asm volatile("" : "+v"(kl));
#pragma unroll
      for (int t = 0; t < 2; ++t)
#pragma unroll
        for (int s = 0; s < KS; ++s) kf[0][t][s] = *(const bf16x8*)(kb + (kl + (unsigned)((4 * t) * kld + 32 * s) * 2u)); }
#pragma unroll
    for (int j = 0; j < 8; ++j) {
        if (j < 7) {
            unsigned kl = klane; asm volatile("" : "+v"(kl));
#pragma unroll
            for (int t = 0; t < 2; ++t)
#pragma unroll
                for (int s = 0; s < KS; ++s) kf[(j + 1) & 1][t][s] = *(const bf16x8*)(kb + (kl + (unsigned)(((j + 1) * kstride + 4 * t) * kld + 32 * s) * 2u));
        }
#pragma unroll
        for (int t = 0; t < 2; ++t) {
            f32x4 a = {0.f, 0.f, 0.f, 0.f};
#pragma unroll
            for (int s = 0; s < KS; ++s) a = __builtin_amdgcn_mfma_f32_16x16x32_bf16(kf[j & 1][t][s], qf[s], a, 0, 0, 0);
            sc[j][t] = a;
        }
        __builtin_amdgcn_sched_barrier(0);
    }
    const int cs = min(max(qc - 8, 0), 48);
    float mx = -1e30f;
#pragma unroll
    for (int j = 0; j < 8; ++j)
#pragma unroll
        for (int t = 0; t < 2; ++t)
#pragma unroll
            for (int jj = 0; jj < 4; ++jj) {
                float v = sc[j][t][jj] * scale;
                if (IS_NA) {
                    const int kc = cb + 8 * g + 4 * t + jj;
                    const bool valid = (kc >= cs) && (kc < cs + 16);
                    const int dc = min(max(kc - qc + 15, 0), 30);
                    v += rpbh[(dr0 + j) * 31 + dc];
                    v = valid ? v : -1e30f;
                }
                sc[j][t][jj] = v; mx = fmaxf(mx, v);
            }
    mx = fmaxf(mx, __shfl_xor(mx, 16)); mx = fmaxf(mx, __shfl_xor(mx, 32));
    float l = 0.f;
#pragma unroll
    for (int j = 0; j < 8; ++j)
#pragma unroll
        for (int t = 0; t < 2; ++t)
#pragma unroll
            for (int jj = 0; jj < 4; ++jj) { const float pv = __expf(sc[j][t][jj] - mx); sc[j][t][jj] = pv; l += pv; }
    l += __shfl_xor(l, 16); l += __shfl_xor(l, 32);
    f32x4 o[MT];
#pragma unroll
    for (int mt = 0; mt < MT; ++mt) o[mt] = (f32x4){0.f, 0.f, 0.f, 0.f};
    bf16x8 vf[2][MT];
    const char* vb = (const char*)VT;
    const unsigned vlane = (unsigned)(i * vld + key0 + 8 * g) * 2u;
    { unsigned vl = vlane; asm volatile("" : "+v"(vl));
#pragma unroll
      for (int mt = 0; mt < MT; ++mt) vf[0][mt] = *(const bf16x8*)(vb + (vl + (unsigned)(16 * mt * vld) * 2u)); }
#pragma unroll
    for (int j = 0; j < 8; ++j) {
        if (j < 7) {
            unsigned vl = vlane; asm volatile("" : "+v"(vl));
#pragma unroll
            for (int mt = 0; mt < MT; ++mt) vf[(j + 1) & 1][mt] = *(const bf16x8*)(vb + (vl + (unsigned)(16 * mt * vld + (j + 1) * kstride) * 2u));
        }
        u32x4 pw; pw.x = pk2(sc[j][0][0], sc[j][0][1]); pw.y = pk2(sc[j][0][2], sc[j][0][3]); pw.z = pk2(sc[j][1][0], sc[j][1][1]); pw.w = pk2(sc[j][1][2], sc[j][1][3]);
        const bf16x8 pf = __builtin_bit_cast(bf16x8, pw);
#pragma unroll
        for (int mt = 0; mt < MT; ++mt) o[mt] = __builtin_amdgcn_mfma_f32_16x16x32_bf16(vf[j & 1][mt], pf, o[mt], 0, 0, 0);
        __builtin_amdgcn_sched_barrier(0);
    }
    const float inv = 1.f / l;
#pragma unroll
    for (int mt = 0; mt < MT; ++mt) {
        u32x2 w; w.x = pk2(o[mt][0] * inv, o[mt][1] * inv); w.y = pk2(o[mt][2] * inv, o[mt][3] * inv);
        *(u32x2*)(Orow + 16 * mt + 4 * g) = w;
    }
}

__device__ __forceinline__ void phase_mixer(const Params& p, LAS unsigned char* lds, int gw, int NGW, int gtid, int NT, int lane) {
    unsigned char* ws = p.ws;
    LAS float* rpbl = (LAS float*)lds;
    for (int i = threadIdx.x; i < 8 * 15 * 31; i += blockDim.x) rpbl[i] = p.rpb[i];
    __syncthreads();
    const bf16_t* QK = (const bf16_t*)(ws + OFF_QK); const bf16_t* VT = (const bf16_t*)(ws + OFF_VT); const bf16_t* GT = (const bf16_t*)(ws + OFF_GT);
    bf16_t* Y = (bf16_t*)(ws + OFF_Y);
    for (int u = gw; u < (SEQ / 16) * 8; u += NGW) {
        const int tb = u >> 3, h = u & 7, r = tb >> 2, qb = tb & 3;
        const int wr0 = min(max(r - 4, 0), 248);
        const int cb = (qb == 0) ? 0 : (qb == 1) ? 8 : (qb == 2) ? 24 : 32;
        const int qc = qb * 16 + (lane & 15), tq = r * 64 + qc;
        attn_unit<64, true>(QK + (size_t)tq * 1024 + h * 64, QK + 512 + h * 64, 1024, VT + (size_t)h * 64 * SEQ, SEQ, wr0 * 64 + cb, 64,
                            Y + (size_t)tq * 1024 + h * 64, 0.125f, lane, rpbl + h * 465, wr0 - r + 7, qc, cb);
    }
    for (int it = gtid; it < SEQ * 64; it += NT) {
        const int t = it >> 6, c8 = (it & 63) * 8;
        float accv[8];
#pragma unroll
        for (int e = 0; e < 8; ++e) accv[e] = 0.f;
#pragma unroll
        for (int dt = 0; dt < 3; ++dt) {
            const int tt = t + dt - 1;
            if (tt >= 0 && tt < SEQ) {
                const u32x4 cg4 = *(const u32x4*)(GT + (size_t)tt * 1536 + 512 + c8), h4 = *(const u32x4*)(GT + (size_t)tt * 1536 + 1024 + c8);
                const f32x4 w0 = *(const f32x4*)(p.conv_w + dt * 512 + c8), w1 = *(const f32x4*)(p.conv_w + dt * 512 + c8 + 4);
                accv[0] += w0[0] * bflo(cg4.x) * bflo(h4.x); accv[1] += w0[1] * bfhi(cg4.x) * bfhi(h4.x);
                accv[2] += w0[2] * bflo(cg4.y) * bflo(h4.y); accv[3] += w0[3] * bfhi(cg4.y) * bfhi(h4.y);
                accv[4] += w1[0] * bflo(cg4.z) * bflo(h4.z); accv[5] += w1[1] * bfhi(cg4.z) * bfhi(h4.z);
                accv[6] += w1[2] * bflo(cg4.w) * bflo(h4.w); accv[7] += w1[3] * bfhi(cg4.w) * bfhi(h4.w);
            }
        }
        const u32x4 b4 = *(const u32x4*)(GT + (size_t)t * 1536 + c8);
        u32x4 o;
        o.x = pk2(accv[0] * bflo(b4.x), accv[1] * bfhi(b4.x)); o.y = pk2(accv[2] * bflo(b4.y), accv[3] * bfhi(b4.y));
        o.z = pk2(accv[4] * bflo(b4.z), accv[5] * bfhi(b4.z)); o.w = pk2(accv[6] * bflo(b4.w), accv[7] * bfhi(b4.w));
        *(u32x4*)(Y + (size_t)t * 1024 + 512 + c8) = o;
    }
}

__device__ __forceinline__ void phase_xattn(const Params& p, int gw, int NGW, int lane) {
    unsigned char* ws = p.ws;
    const bf16_t* Q2 = (const bf16_t*)(ws + OFF_Q2); const bf16_t* KM = (const bf16_t*)(ws + OFF_KMEM); const bf16_t* VM = (const bf16_t*)(ws + OFF_VMEMT);
    bf16_t* O = (bf16_t*)(ws + OFF_O);
    for (int u = gw; u < (SEQ / 16) * 4; u += NGW) {
        const int tb = u >> 2, h = u & 3, tq = tb * 16 + (lane & 15);
        attn_unit<128, false>(Q2 + (size_t)tq * 512 + h * 128, KM + h * 128, 512, VM + (size_t)h * 128 * 256, 256, 0, 32,
                              O + (size_t)tq * 512 + h * 128, 0.08838834764831845f, lane, nullptr, 0, 0, 0);
    }
}

__device__ __forceinline__ void ln_row(f32x4 (&v)[4], const float* __restrict__ gm, const float* __restrict__ bt, int lane) {
    float s = 0.f;
#pragma unroll
    for (int j = 0; j < 4; ++j) s += (v[j][0] + v[j][1]) + (v[j][2] + v[j][3]);
    const float mean = wave_sum(s) * (1.f / DM);
    float s2 = 0.f;
#pragma unroll
    for (int j = 0; j < 4; ++j) { v[j] = v[j] - mean; s2 += (v[j][0] * v[j][0] + v[j][1] * v[j][1]) + (v[j][2] * v[j][2] + v[j][3] * v[j][3]); }
    const float rstd = 1.f / sqrtf(wave_sum(s2) * (1.f / DM) + LNEPS);
#pragma unroll
    for (int j = 0; j < 4; ++j) {
        const f32x4 g4 = *(const f32x4*)(gm + 4 * lane + 256 * j), b4 = *(const f32x4*)(bt + 4 * lane + 256 * j);
        v[j] = v[j] * rstd * g4 + b4;
    }
}
__device__ __forceinline__ void store_row_bf16(bf16_t* row, const f32x4 (&v)[4], int lane) {
#pragma unroll
    for (int j = 0; j < 4; ++j) { u32x2 w; w.x = pk2(v[j][0], v[j][1]); w.y = pk2(v[j][2], v[j][3]); *(u32x2*)(row + 4 * lane + 256 * j) = w; }
}
__device__ __forceinline__ void phase_ln1(const Params& p, int gw, int NGW, int lane) {
    float* Z = (float*)(p.ws + OFF_RB); bf16_t* XB = (bf16_t*)(p.ws + OFF_XB);
    for (int row = gw; row < SEQ; row += NGW) {
        float* zr = Z + (size_t)row * DM; f32x4 v[4];
#pragma unroll
        for (int j = 0; j < 4; ++j) v[j] = *(const f32x4*)(zr + 4 * lane + 256 * j);
        ln_row(v, p.ln1g, p.ln1b, lane);
#pragma unroll
        for (int j = 0; j < 4; ++j) *(f32x4*)(zr + 4 * lane + 256 * j) = v[j];
        store_row_bf16(XB + (size_t)row * DM, v, lane);
    }
}
__device__ __forceinline__ void phase_ln2_router(const Params& p, LAS unsigned char* lds, int gw, int NGW, int lane) {
    LAS float* wT = (LAS float*)lds;
    for (int i = threadIdx.x; i < DM * NEXP; i += blockDim.x) wT[(i & 15) * DM + (i >> 4)] = p.w_router[i];
    __syncthreads();
    float* Z = p.out; bf16_t* XB = (bf16_t*)(p.ws + OFF_X2B); float* affT = (float*)(p.ws + OFF_AFFT);
    for (int row = gw; row < SEQ; row += NGW) {
        float* zr = Z + (size_t)row * DM; f32x4 v[4];
#pragma unroll
        for (int j = 0; j < 4; ++j) v[j] = *(const f32x4*)(zr + 4 * lane + 256 * j);
        ln_row(v, p.ln2g, p.ln2b, lane);
#pragma unroll
        for (int j = 0; j < 4; ++j) *(f32x4*)(zr + 4 * lane + 256 * j) = v[j];
        store_row_bf16(XB + (size_t)row * DM, v, lane);
        float lg[NEXP];
#pragma unroll
        for (int e = 0; e < NEXP; ++e) {
            float a = 0.f;
#pragma unroll
            for (int j = 0; j < 4; ++j) { const f32x4 w = *(const LAS f32x4*)(wT + e * DM + 4 * lane + 256 * j); a += (v[j][0] * w[0] + v[j][1] * w[1]) + (v[j][2] * w[2] + v[j][3] * w[3]); }
            lg[e] = wave_sum(a);
            __builtin_amdgcn_sched_barrier(0);
        }
        float mx = lg[0];
#pragma unroll
        for (int e = 1; e < NEXP; ++e) mx = fmaxf(mx, lg[e]);
        float sum = 0.f;
#pragma unroll
        for (int e = 0; e < NEXP; ++e) { lg[e] = expf(lg[e] - mx); sum += lg[e]; }
        float mine = 0.f;
#pragma unroll
        for (int e = 0; e < NEXP; ++e) mine = (lane == e) ? lg[e] : mine;
        if (lane < NEXP) affT[(size_t)lane * SEQ + row] = mine / sum;
    }
}
__device__ __forceinline__ void phase_final(const Params& p, int gw, int NGW, int lane) {
    float* Z = p.out; const bf16_t* YE = (const bf16_t*)(p.ws + OFF_RB); const int* inv = (const int*)(p.ws + OFF_INV); const float* gate = (const float*)(p.ws + OFF_GATE);
    for (int row = gw; row < SEQ; row += NGW) {
        float* zr = Z + (size_t)row * DM; f32x4 v[4];
#pragma unroll
        for (int j = 0; j < 4; ++j) v[j] = *(const f32x4*)(zr + 4 * lane + 256 * j) * ALPHA;
        const int myinv = (lane < NEXP) ? inv[(size_t)row * NEXP + lane] : -1;
        const float mygate = (myinv >= 0) ? gate[lane * CAP + myinv] : 0.f;
#pragma unroll
        for (int e = 0; e < NEXP; ++e) {
            const int slot = __builtin_amdgcn_readlane(myinv, e);
            if (slot >= 0) {
                const float gt = __builtin_bit_cast(float, __builtin_amdgcn_readlane(__builtin_bit_cast(int, mygate), e));
                const bf16_t* yr = YE + (size_t)(e * CAP + slot) * DM;
#pragma unroll
                for (int j = 0; j < 4; ++j) { const u32x2 w = *(const u32x2*)(yr + 4 * lane + 256 * j); v[j][0] += gt * bflo(w.x); v[j][1] += gt * bfhi(w.x); v[j][2] += gt * bflo(w.y); v[j][3] += gt * bfhi(w.y); }
            }
        }
        ln_row(v, p.ln3g, p.ln3b, lane);
#pragma unroll
        for (int j = 0; j < 4; ++j) *(f32x4*)(zr + 4 * lane + 256 * j) = v[j];
    }
}

__device__ __forceinline__ int block_excl_scan(int v, LAS int* tmp, int tid) {
    const int lane = tid & 63, wave = tid >> 6;
    int incl = v;
#pragma unroll
    for (int o = 1; o < 64; o <<= 1) { const int t = __shfl_up(incl, o); if (lane >= o) incl += t; }
    __syncthreads();
    if (lane == 63) tmp[wave] = incl;
    __syncthreads();
    int base = 0;
#pragma unroll
    for (int w = 0; w < 8; ++w) base += (w < wave) ? tmp[w] : 0;
    return base + incl - v;
}
__device__ __forceinline__ void phase_topk(const Params& p, LAS unsigned char* lds, int e) {
    const int tid = threadIdx.x, lane = tid & 63, wave = tid >> 6;
    LAS unsigned* hist = (LAS unsigned*)lds; LAS unsigned* ctl = hist + 256; LAS int* tmp = (LAS int*)(hist + 272);
    LAS unsigned* vals = hist + 320;
    const unsigned* affT = (const unsigned*)(p.ws + OFF_AFFT) + (size_t)e * SEQ;
    int* idx = (int*)(p.ws + OFF_IDX); float* gate = (float*)(p.ws + OFF_GATE); int* inv = (int*)(p.ws + OFF_INV);
#pragma unroll 4
    for (int k = 0; k < 32; ++k) { const int t = k * 512 + tid; vals[t + (t >> 5)] = affT[t]; }
    __syncthreads();
    const LAS unsigned* mine = vals + tid * 33;
    unsigned prefix = 0, need = CAP;
#pragma unroll 1
    for (int ps = 3; ps >= 0; --ps) {
        const int shift = 8 * ps;
        const unsigned maskhi = (ps == 3) ? 0u : (0xFFFFFFFFu << (shift + 8));
        if (tid < 256) hist[tid] = 0;
        __syncthreads();
#pragma unroll 4
        for (int i = 0; i < 32; ++i) { const unsigned x = mine[i]; if ((x & maskhi) == prefix) __hip_atomic_fetch_add(&hist[(x >> shift) & 255], 1u, __ATOMIC_RELAXED, __HIP_MEMORY_SCOPE_WORKGROUP); }
        __syncthreads();
        if (wave == 0) {
            const unsigned c0 = hist[255 - 4 * lane], c1 = hist[254 - 4 * lane], c2 = hist[253 - 4 * lane], c3 = hist[252 - 4 * lane];
            const unsigned s = c0 + c1 + c2 + c3;
            unsigned incl = s;
#pragma unroll
            for (int o = 1; o < 64; o <<= 1) { const unsigned t = __shfl_up(incl, o); if (lane >= o) incl += t; }
            const unsigned excl = incl - s;
            if (excl < need && need <= incl) {
                unsigned rem = need - excl; int bin;
                if (rem <= c0) bin = 255 - 4 * lane;
                else { rem -= c0; if (rem <= c1) bin = 254 - 4 * lane; else { rem -= c1; if (rem <= c2) bin = 253 - 4 * lane; else { rem -= c2; bin = 252 - 4 * lane; } } }
                ctl[0] = prefix | ((unsigned)bin << shift); ctl[1] = rem;
            }
        }
        __syncthreads();
        prefix = ctl[0]; need = ctl[1];
        __syncthreads();
    }
    const unsigned T = prefix;
    int ngt = 0, neq = 0;
#pragma unroll 4
    for (int i = 0; i < 32; ++i) { const unsigned x = mine[i]; ngt += (x > T) ? 1 : 0; neq += (x == T) ? 1 : 0; }
    const int eq_before = block_excl_scan(neq, tmp, tid);
    const int take_eq = min(max((int)need - eq_before, 0), neq);
    const int sel_before = block_excl_scan(ngt + take_eq, tmp, tid);
    int slot = sel_before, eqr = eq_before;
#pragma unroll 2
    for (int i = 0; i < 32; ++i) {
        const int t = tid * 32 + i;
        const unsigned x = mine[i];
        const bool iseq = (x == T);
        const bool sl = (x > T) || (iseq && eqr < (int)need);
        eqr += iseq ? 1 : 0;
        if (sl) { idx[e * CAP + slot] = t; gate[e * CAP + slot] = __uint_as_float(x); ++slot; }
        inv[(size_t)t * NEXP + e] = sl ? (slot - 1) : -1;
    }
}
__device__ __forceinline__ void phase_gather(const Params& p, int gw, int NGW, int lane) {
    const bf16_t* XB = (const bf16_t*)(p.ws + OFF_X2B); bf16_t* XE = (bf16_t*)(p.ws + OFF_RB); const int* idx = (const int*)(p.ws + OFF_IDX);
    for (int row = gw; row < NEXP * CAP; row += NGW) {
        const int t = idx[row];
        const u32x4* s = (const u32x4*)(XB + (size_t)t * DM); u32x4* d = (u32x4*)(XE + (size_t)row * DM);
        const u32x4 a = s[lane], b = s[64 + lane];
        d[lane] = a; d[64 + lane] = b;
    }
}


#define XB_TMO      128
#define XB_XCNT(j)  (256  + 64 * (j))
#define XB_XSUB(j)  (1280 + 64 * (j))
#define XB_XGEN(j)  (2304 + 64 * (j))
#define XB_TOP      3328
#define XB_TOPGEN   3392
#define XCD_BAR_WORDS 3456
#define XB_SPIN_CAP (1u << 18)
__device__ __forceinline__ unsigned xb_ld(unsigned* p)              { return __hip_atomic_load(p, __ATOMIC_RELAXED, __HIP_MEMORY_SCOPE_AGENT); }
__device__ __forceinline__ unsigned xb_add(unsigned* p, unsigned v) { return __hip_atomic_fetch_add(p, v, __ATOMIC_RELAXED, __HIP_MEMORY_SCOPE_AGENT); }
__device__ __forceinline__ unsigned xb_xcc_id() { return (unsigned)__builtin_amdgcn_s_getreg((3 << 11) | 20) & 0xFu; }
#define XB_SPIN(cond, bar) do { unsigned _sp = 0; while (cond) { __builtin_amdgcn_s_sleep(1); \
    if ((++_sp & 255u) == 0u) { if (xb_ld(&(bar)[XB_TMO])) break; if (_sp > XB_SPIN_CAP) { atomicAdd(&(bar)[XB_TMO], 1u); break; } } } } while (0)
struct XcdBarrier { unsigned* bar; unsigned x; volatile LAS unsigned* st; };
__device__ __forceinline__ XcdBarrier xcd_barrier_post(unsigned* bar, volatile LAS unsigned* st) {
    XcdBarrier b; b.bar = bar; b.x = xb_xcc_id(); b.st = st;
    if (threadIdx.x == 0) (void)xb_add(&bar[XB_XCNT(b.x)], 1u);
    return b;
}
__device__ __forceinline__ void xcd_barrier_complete(unsigned* bar, unsigned x, unsigned& nloc, unsigned& nx) {
    const unsigned G = gridDim.x * gridDim.y * gridDim.z;
    unsigned sum, cnt, mine, sp = 0u;
    for (;;) {
        sum = 0u; cnt = 0u; mine = 0u;
#pragma unroll
        for (unsigned j = 0; j < 16; ++j) { const unsigned c = xb_ld(&bar[XB_XCNT(j)]); sum += c; cnt += (c > 0u) ? 1u : 0u; mine = (j == x) ? c : mine; }
        if (sum == G) break;
        __builtin_amdgcn_s_sleep(1);
        if ((++sp & 255u) == 0u) { if (xb_ld(&bar[XB_TMO])) break; if (sp > XB_SPIN_CAP) { atomicAdd(&bar[XB_TMO], 1u); break; } }
    }
    nloc = mine > 0u ? mine : 1u; nx = cnt > 0u ? cnt : 1u;
}
__device__ __forceinline__ void xcd_barrier(const XcdBarrier& b) {
    asm volatile("s_waitcnt vmcnt(0)" ::: "memory");
    __syncthreads();
    if (threadIdx.x == 0) {
        unsigned* bar = b.bar;
        __builtin_amdgcn_s_waitcnt(0);
        unsigned nloc = b.st[0], nx = b.st[1];
        if (nloc == 0u) { xcd_barrier_complete(bar, b.x, nloc, nx); b.st[0] = nloc; b.st[1] = nx; }
        const unsigned old = xb_add(&bar[XB_XSUB(b.x)], 1u);
        const unsigned gen = old / nloc;
        if (old + 1u == (gen + 1u) * nloc) {
            __builtin_amdgcn_fence(__ATOMIC_RELEASE, "agent");
            asm volatile("s_waitcnt vmcnt(0)" ::: "memory");
            const unsigned og = xb_add(&bar[XB_TOP], 1u);
            const unsigned tg = og / nx;
            if (og + 1u == (tg + 1u) * nx) xb_add(&bar[XB_TOPGEN], 1u);
            else XB_SPIN(xb_ld(&bar[XB_TOPGEN]) == tg, bar);
            __builtin_amdgcn_fence(__ATOMIC_ACQUIRE, "agent");
            xb_add(&bar[XB_XGEN(b.x)], 1u);
            asm volatile("s_waitcnt vmcnt(0)" ::: "memory");
        } else {
            XB_SPIN(xb_ld(&bar[XB_XGEN(b.x)]) == gen, bar);
            __builtin_amdgcn_fence(__ATOMIC_ACQUIRE, "agent");
            asm volatile("s_waitcnt vmcnt(0)" ::: "memory");
        }
    }
    __syncthreads();
}

#ifndef PHMASK
#define PHMASK 0xFFFF
#endif
#ifndef DUPMASK
#define DUPMASK 0
#endif
#ifndef XSYNC
#define XSYNC 0
#endif
#define PH(n) if ((PHMASK >> (n)) & 1)
#define DUP(n) if ((DUPMASK >> (n)) & 1)
__global__ void __launch_bounds__(512, 2) fwd_megakernel(Params p_arg) {
    const Params& p = *(const Params*)__builtin_amdgcn_kernarg_segment_ptr();
    extern __shared__ __attribute__((aligned(16))) unsigned char shm[];
    LAS unsigned char* lds = (LAS unsigned char*)shm;
    cg::grid_group grid = cg::this_grid();
    volatile LAS unsigned* xst = (volatile LAS unsigned*)(lds + LDS_BYTES - 16);
    if (threadIdx.x == 0) { xst[0] = 0u; xst[1] = 0u; }
    __syncthreads();
    (void)xcd_barrier_post((unsigned*)(p.ws + OFF_CTL), xst);
#define XBAR() do { XcdBarrier _b; _b.bar = (unsigned*)(p.ws + OFF_CTL); _b.x = xb_xcc_id(); _b.st = (volatile LAS unsigned*)(lds + LDS_BYTES - 16); xcd_barrier(_b); } while (0)
    if (p.ws == nullptr) grid.sync();
    const int tid = threadIdx.x, lane = tid & 63, wave = __builtin_amdgcn_readfirstlane(tid >> 6);
    const int G = gridDim.x, c = blockIdx.x;
    const int gw = c * 8 + wave, NGW = G * 8, gtid = c * 512 + tid, NT = G * 512;
    unsigned char* ws = p.ws;

    PH(0) phase_convert(p, lds, gw, NGW, gtid, NT, wave, lane);
    DUP(0) phase_convert(p, lds, gw, NGW, gtid, NT, wave, lane);
    XBAR();
    PH(1) { SchedG1 S{(const char*)(ws + OFF_XB), (const char*)(ws + OFF_WIN), (char*)(ws + OFF_QK), (char*)(ws + OFF_VT), (char*)(ws + OFF_GT), G, c};
      pg8::gemm_phase(lds, 1024, S, pg8::EpiBf16{}); }
    DUP(1) { SchedG1 S{(const char*)(ws + OFF_XB), (const char*)(ws + OFF_WIN), (char*)(ws + OFF_QK), (char*)(ws + OFF_VT), (char*)(ws + OFF_GT), G, c};
      pg8::gemm_phase(lds, 1024, S, pg8::EpiBf16{}); }
    XBAR();
    PH(2) phase_mixer(p, lds, gw, NGW, gtid, NT, lane);
    DUP(2) phase_mixer(p, lds, gw, NGW, gtid, NT, lane);
    XBAR();
    PH(3) { SchedRes S{(const char*)(ws + OFF_Y), (const char*)(ws + OFF_WOUT), (char*)(ws + OFF_RB), (const char*)p.x, 1024, G, c};
      pg8::gemm_phase(lds, 1024, S, pg8::EpiRes{}); }
    DUP(3) { SchedRes S{(const char*)(ws + OFF_Y), (const char*)(ws + OFF_WOUT), (char*)(ws + OFF_RB), (const char*)p.x, 1024, G, c};
      pg8::gemm_phase(lds, 1024, S, pg8::EpiRes{}); }
    XBAR();
    PH(4) phase_ln1(p, gw, NGW, lane);
    DUP(4) phase_ln1(p, gw, NGW, lane);
    XBAR();
    PH(5) { SchedG3 S{(const char*)(ws + OFF_XB), (const char*)(ws + OFF_WQ), (const char*)(ws + OFF_WK), (const char*)(ws + OFF_WV), (const char*)(ws + OFF_MEMB),
                (char*)(ws + OFF_Q2), (char*)(ws + OFF_KMEM), (char*)(ws + OFF_VMEMT), G, c};
      pg8::gemm_phase(lds, 1024, S, pg8::EpiBf16{}); }
    DUP(5) { SchedG3 S{(const char*)(ws + OFF_XB), (const char*)(ws + OFF_WQ), (const char*)(ws + OFF_WK), (const char*)(ws + OFF_WV), (const char*)(ws + OFF_MEMB),
                (char*)(ws + OFF_Q2), (char*)(ws + OFF_KMEM), (char*)(ws + OFF_VMEMT), G, c};
      pg8::gemm_phase(lds, 1024, S, pg8::EpiBf16{}); }
    XBAR();
    PH(6) phase_xattn(p, gw, NGW, lane);
    DUP(6) phase_xattn(p, gw, NGW, lane);
    XBAR();
    PH(7) { SchedRes S{(const char*)(ws + OFF_O), (const char*)(ws + OFF_WMO), (char*)p.out, (const char*)(ws + OFF_RB), 512, G, c};
      pg8::gemm_phase(lds, 512, S, pg8::EpiRes{}); }
    DUP(7) { SchedRes S{(const char*)(ws + OFF_O), (const char*)(ws + OFF_WMO), (char*)p.out, (const char*)(ws + OFF_RB), 512, G, c};
      pg8::gemm_phase(lds, 512, S, pg8::EpiRes{}); }
    XBAR();
    PH(8) phase_ln2_router(p, lds, gw, NGW, lane);
    DUP(8) phase_ln2_router(p, lds, gw, NGW, lane);
    XBAR();
    PH(9) if (c < NEXP) phase_topk(p, lds, c);
    DUP(9) if (c < NEXP) phase_topk(p, lds, c);
    XBAR();
    PH(10) phase_gather(p, gw, NGW, lane);
    DUP(10) phase_gather(p, gw, NGW, lane);
    XBAR();
    PH(11) { SchedG5 S{(const char*)(ws + OFF_RB), (const char*)(ws + OFF_WGU), (char*)(ws + OFF_HID), G, c};
      pg8::gemm_phase(lds, 1024, S, pg8::EpiSwiGLU{}); }
    DUP(11) { SchedG5 S{(const char*)(ws + OFF_RB), (const char*)(ws + OFF_WGU), (char*)(ws + OFF_HID), G, c};
      pg8::gemm_phase(lds, 1024, S, pg8::EpiSwiGLU{}); }
    XBAR();
    PH(12) { SchedG6 S{(const char*)(ws + OFF_HID), (const char*)(ws + OFF_WD), (char*)(ws + OFF_RB), G, c};
      pg8::gemm_phase(lds, 2048, S, pg8::EpiBf16{}); }
    DUP(12) { SchedG6 S{(const char*)(ws + OFF_HID), (const char*)(ws + OFF_WD), (char*)(ws + OFF_RB), G, c};
      pg8::gemm_phase(lds, 2048, S, pg8::EpiBf16{}); }
    XBAR();
    for (int _x = 0; _x < XSYNC; ++_x) XBAR();
    PH(13) phase_final(p, gw, NGW, lane);
    DUP(13) phase_final(p, gw, NGW, lane);
}

extern "C" void kernel_launch(void* const* d_in, const int* in_sizes, int n_in, void* d_out, int out_size, void* d_ws, size_t ws_size, hipStream_t stream) {
    static int grid_blocks = 0;
    if (grid_blocks == 0) {
        if (n_in != 20 || out_size != SEQ * DM || ws_size < WS_END) { fprintf(stderr, "kernel_launch: unexpected shapes (n_in %d, out %d, ws %zu)\n", n_in, out_size, ws_size); grid_blocks = -1; return; }
        int dev = 0, cus = 0, per_cu = 0;
        hipGetDevice(&dev);
        hipDeviceGetAttribute(&cus, hipDeviceAttributeMultiprocessorCount, dev);
        if (hipFuncSetAttribute((const void*)fwd_megakernel, hipFuncAttributeMaxDynamicSharedMemorySize, LDS_BYTES) != hipSuccess) { fprintf(stderr, "kernel_launch: hipFuncSetAttribute failed\n"); grid_blocks = -1; return; }
        if (hipOccupancyMaxActiveBlocksPerMultiprocessor(&per_cu, (const void*)fwd_megakernel, 512, LDS_BYTES) != hipSuccess || per_cu < 1) per_cu = 1;
        (void)hipGetLastError();
        grid_blocks = cus * per_cu;
    }
    if (grid_blocks < 0) return;
    if (hipMemsetAsync((char*)d_ws + OFF_CTL, 0, XCD_BAR_WORDS * 4, stream) != hipSuccess) { fprintf(stderr, "kernel_launch: memset failed\n"); return; }
    Params p{};
    const float** f = (const float**)&p;
    for (int i = 0; i < 20; ++i) f[i] = (const float*)d_in[i];
    p.out = (float*)d_out; p.ws = (unsigned char*)d_ws;
    void* args[] = {&p};
    hipError_t e = hipLaunchCooperativeKernel((const void*)fwd_megakernel, dim3(grid_blocks), dim3(512), args, LDS_BYTES, stream);
    if (e != hipSuccess) fprintf(stderr, "cooperative launch failed: %s (grid %d)\n", hipGetErrorString(e), grid_blocks);
}
```

```cpp
#include <hip/hip_runtime.h>
#include <hip/hip_cooperative_groups.h>
#include <cstdio>
#include <cstdint>
namespace cg = cooperative_groups;

#define LAS __attribute__((address_space(3)))
typedef unsigned short bf16_t;
typedef short bf16x8 __attribute__((ext_vector_type(8)));
typedef float f32x4 __attribute__((ext_vector_type(4)));
typedef float f32x2 __attribute__((ext_vector_type(2)));
typedef unsigned u32x4 __attribute__((ext_vector_type(4)));
typedef unsigned u32x2 __attribute__((ext_vector_type(2)));
typedef __bf16 bfv2 __attribute__((ext_vector_type(2)));

constexpr int SEQ = 16384, DM = 1024, MEMLEN = 256, NEXP = 16, CAP = 2048, FF = 2048;
constexpr float ALPHA = 1.189207115002721f;
constexpr float LNEPS = 1e-5f;
constexpr size_t MiB = 1u << 20;
constexpr size_t OFF_WIN = 0, OFF_WOUT = 6 * MiB, OFF_WQ = 8 * MiB, OFF_WK = 9 * MiB, OFF_WV = 10 * MiB, OFF_WMO = 11 * MiB,
                 OFF_MEMB = 12 * MiB, OFF_KMEM = 12 * MiB + 512 * 1024, OFF_VMEMT = 12 * MiB + 768 * 1024,
                 OFF_AFFT = 13 * MiB, OFF_INV = 14 * MiB, OFF_IDX = 15 * MiB, OFF_GATE = 15 * MiB + 128 * 1024, OFF_CTL = 15 * MiB + 256 * 1024,
                 OFF_WGU = 16 * MiB, OFF_WD = 144 * MiB,
                 OFF_RA = 208 * MiB, OFF_QK = OFF_RA, OFF_VT = 240 * MiB, OFF_GT = 256 * MiB, OFF_Y = 304 * MiB, OFF_HID = OFF_RA,
                 OFF_RB = 336 * MiB,
                 OFF_XB = 400 * MiB,
                 OFF_Q2 = 432 * MiB, OFF_O = 448 * MiB, OFF_X2B = OFF_Q2,
                 WS_END = 464 * MiB;
constexpr int LDS_BYTES = 136 * 1024;

struct Params {
    const float *x, *mem, *w_in, *rpb, *conv_w, *w_out, *ln1g, *ln1b, *wq, *wk, *wv, *wmo, *ln2g, *ln2b, *w_router, *weg, *weu, *wed, *ln3g, *ln3b;
    float* out; unsigned char* ws;
};

__device__ __forceinline__ unsigned pk2(float a, float b) { f32x2 f = {a, b}; bfv2 r = __builtin_convertvector(f, bfv2); return __builtin_bit_cast(unsigned, r); }
__device__ __forceinline__ float bflo(unsigned w) { return __uint_as_float(w << 16); }
__device__ __forceinline__ float bfhi(unsigned w) { return __uint_as_float(w & 0xffff0000u); }
__device__ __forceinline__ float wave_sum(float v) {
#pragma unroll
    for (int o = 1; o < 64; o <<= 1) v += __shfl_xor(v, o);
    return v;
}

namespace pg8 {
constexpr int BM = 256, BK = 64, HALF = 128, HTB = HALF * BK * 2, STAGE_BYTES = 8 * HTB;
__device__ __forceinline__ int lds_byte(int r, int c) { const int st = (r >> 4) * 2 + (c >> 5), rr = r & 15, cc = c & 31, ob = rr * 64 + cc * 2; return st * 1024 + (ob ^ (((ob >> 9) & 1) << 5)); }
__device__ __forceinline__ void stage_rc(int b, int& R, int& C) { const int st = b / 1024, sb = b % 1024, swz = sb ^ (((sb >> 9) & 1) << 5); R = (st >> 1) * 16 + swz / 64; C = (st & 1) * 32 + (swz % 64) / 2; }
__device__ __forceinline__ int perm32(int rho) { const int n = rho >> 4, i = rho & 15; return 8 * (i >> 2) + 4 * n + (i & 3); }

struct Unit { const char* A; const char* B; char* O; const char* R; int ldc; int aux; };

struct EpiBf16 {
    static constexpr bool PERM = true;
    __device__ __forceinline__ void operator()(const f32x4 (&acc)[2][2][4][2], const Unit& u, int wr, int wc, int fr, int fq) const {
        bf16_t* O = (bf16_t*)u.O;
#pragma unroll
        for (int ai = 0; ai < 2; ++ai)
#pragma unroll
            for (int m = 0; m < 4; ++m) {
                bf16_t* rowp = O + (size_t)(ai * 128 + wr * 64 + m * 16 + fr) * u.ldc + wc * 32 + 8 * fq;
#pragma unroll
                for (int bj = 0; bj < 2; ++bj) {
                    const f32x4 a0 = acc[ai][bj][m][0], a1 = acc[ai][bj][m][1];
                    u32x4 o; o.x = pk2(a0[0], a0[1]); o.y = pk2(a0[2], a0[3]); o.z = pk2(a1[0], a1[1]); o.w = pk2(a1[2], a1[3]);
                    *(u32x4*)(rowp + bj * 128) = o;
                }
            }
    }
};
struct EpiGate {
    static constexpr bool PERM = true;
    const float* gate;
    __device__ __forceinline__ void operator()(const f32x4 (&acc)[2][2][4][2], const Unit& u, int wr, int wc, int fr, int fq) const {
        bf16_t* O = (bf16_t*)u.O;
#pragma unroll
        for (int ai = 0; ai < 2; ++ai)
#pragma unroll
            for (int m = 0; m < 4; ++m) {
                const int row = ai * 128 + wr * 64 + m * 16 + fr;
                const float gt = gate[u.aux + row];
                bf16_t* rowp = O + (size_t)row * u.ldc + wc * 32 + 8 * fq;
#pragma unroll
                for (int bj = 0; bj < 2; ++bj) {
                    const f32x4 a0 = acc[ai][bj][m][0] * gt, a1 = acc[ai][bj][m][1] * gt;
                    u32x4 o; o.x = pk2(a0[0], a0[1]); o.y = pk2(a0[2], a0[3]); o.z = pk2(a1[0], a1[1]); o.w = pk2(a1[2], a1[3]);
                    *(u32x4*)(rowp + bj * 128) = o;
                }
            }
    }
};
struct EpiRes {
    static constexpr bool PERM = false;
    __device__ __forceinline__ void operator()(const f32x4 (&acc)[2][2][4][2], const Unit& u, int wr, int wc, int fr, int fq) const {
        float* Z = (float*)u.O; const float* R = (const float*)u.R;
#pragma unroll
        for (int ai = 0; ai < 2; ++ai)
#pragma unroll
            for (int m = 0; m < 4; ++m) {
                const size_t ro = (size_t)(ai * 128 + wr * 64 + m * 16 + fr) * u.ldc + wc * 32 + 4 * fq;
#pragma unroll
                for (int bj = 0; bj < 2; ++bj)
#pragma unroll
                    for (int n = 0; n < 2; ++n) {
                        const f32x4 r = *(const f32x4*)(R + ro + bj * 128 + n * 16);
                        *(f32x4*)(Z + ro + bj * 128 + n * 16) = acc[ai][bj][m][n] + r * ALPHA;
                    }
            }
    }
};
__device__ __forceinline__ float swi(float g, float u) { return g * u / (1.f + __expf(-g)); }
struct EpiSwiGLU {
    static constexpr bool PERM = true;
    __device__ __forceinline__ void operator()(const f32x4 (&acc)[2][2][4][2], const Unit& u, int wr, int wc, int fr, int fq) const {
        bf16_t* O = (bf16_t*)u.O;
#pragma unroll
        for (int ai = 0; ai < 2; ++ai)
#pragma unroll
            for (int m = 0; m < 4; ++m) {
                bf16_t* rowp = O + (size_t)(ai * 128 + wr * 64 + m * 16 + fr) * u.ldc + wc * 32 + 8 * fq;
                const f32x4 g0 = acc[ai][0][m][0], g1 = acc[ai][0][m][1], u0 = acc[ai][1][m][0], u1 = acc[ai][1][m][1];
                u32x4 o;
                o.x = pk2(swi(g0[0], u0[0]), swi(g0[1], u0[1])); o.y = pk2(swi(g0[2], u0[2]), swi(g0[3], u0[3]));
                o.z = pk2(swi(g1[0], u1[0]), swi(g1[1], u1[1])); o.w = pk2(swi(g1[2], u1[2]), swi(g1[3], u1[3]));
                *(u32x4*)rowp = o;
            }
    }
};

template <class Epi, class Sched>
__device__ __forceinline__ void gemm_phase(LAS unsigned char* lds, const int K, const Sched& S, const Epi& E) {
    int tid = threadIdx.x; asm volatile("" : "+v"(tid));
    const int wid = __builtin_amdgcn_readfirstlane(tid >> 6), lane = tid & 63, wr = wid >> 2, wc = wid & 3, fr = lane & 15, fq = lane >> 4;
    const int nt = K / BK;
    unsigned voffA[2], voffB[2];
#pragma unroll
    for (int i = 0; i < 2; ++i) { int R, C; stage_rc(tid * 16 + i * 8192, R, C); const int Rb = Epi::PERM ? ((R & ~31) + perm32(R & 31)) : R;
        voffA[i] = (unsigned)(R * K + C) * 2u; voffB[i] = (unsigned)(Rb * K + C) * 2u; }
    const size_t kstep = (size_t)(BK * 2);
    const size_t hstep = (size_t)HALF * K * 2;
    const unsigned ldsw = (unsigned)wid * 1024u;
    const int aoff = lds_byte(wr * 64 + fr, fq * 8), boff = lds_byte(wc * 32 + fr, fq * 8);
#define PG8_SA(b, h) (((b) * 2 + (h)) * HTB)
#define PG8_SB(b, h) ((4 + (b) * 2 + (h)) * HTB)
#define PG8_STAGE(bufoff, gbase, voff) do { _Pragma("unroll") for (int _i = 0; _i < 2; ++_i) \
        __builtin_amdgcn_global_load_lds((const unsigned*)((const char*)(gbase) + (voff)[_i]), (LAS unsigned*)(lds + (bufoff) + ldsw + _i * 8192), 16, 0, 0); } while (0)
#define PG8_LDA(dst, b, h) do { _Pragma("unroll") for (int m = 0; m < 4; ++m) _Pragma("unroll") for (int k = 0; k < 2; ++k) dst[m][k] = *(const LAS bf16x8*)(lds + PG8_SA(b, h) + aoff + m * 2048 + k * 1024); } while (0)
#define PG8_LDB(dst, b, h) do { _Pragma("unroll") for (int n = 0; n < 2; ++n) _Pragma("unroll") for (int k = 0; k < 2; ++k) dst[n][k] = *(const LAS bf16x8*)(lds + PG8_SB(b, h) + boff + n * 2048 + k * 1024); } while (0)
#define PG8_MMA(ai, bj, At, Bt) do { __builtin_amdgcn_s_setprio(1); _Pragma("unroll") for (int m = 0; m < 4; ++m) _Pragma("unroll") for (int n = 0; n < 2; ++n) _Pragma("unroll") for (int k = 0; k < 2; ++k) \
        acc[ai][bj][m][n] = __builtin_amdgcn_mfma_f32_16x16x32_bf16(Bt[n][k], At[m][k], acc[ai][bj][m][n], 0, 0, 0); __builtin_amdgcn_s_setprio(0); } while (0)
#define PG8_WAIT_V(n) asm volatile("s_waitcnt vmcnt(" #n ")" ::: "memory")
#define PG8_WAIT_L(n) asm volatile("s_waitcnt lgkmcnt(" #n ")" ::: "memory")
#define PG8_BAR __builtin_amdgcn_s_barrier()
#define PG8_SCHED __builtin_amdgcn_sched_barrier(0)
    Unit cur, nxt; int ui = 0;
    if (!S.next(0, cur)) return;
    f32x4 acc[2][2][4][2];
#pragma unroll
    for (int a = 0; a < 2; ++a)
#pragma unroll
        for (int b = 0; b < 2; ++b)
#pragma unroll
            for (int m = 0; m < 4; ++m)
#pragma unroll
                for (int n = 0; n < 2; ++n) acc[a][b][m][n] = (f32x4){0.f, 0.f, 0.f, 0.f};
    bf16x8 At[4][2], B0[2][2], B1[2][2];
    const char* cA = cur.A; const char* cB = cur.B;
    PG8_STAGE(PG8_SB(0, 0), cB, voffB); PG8_STAGE(PG8_SA(0, 0), cA, voffA); PG8_STAGE(PG8_SB(0, 1), cB + hstep, voffB); PG8_STAGE(PG8_SA(0, 1), cA + hstep, voffA);
    if (wr == 1) PG8_BAR;
    PG8_WAIT_V(4); PG8_BAR;
    PG8_STAGE(PG8_SB(1, 0), cB + kstep, voffB); PG8_STAGE(PG8_SA(1, 0), cA + kstep, voffA); PG8_STAGE(PG8_SB(1, 1), cB + hstep + kstep, voffB);
    PG8_WAIT_V(6); PG8_BAR;
    for (;;) {
        const bool has_next = S.next(ui + 1, nxt);
        const char* nA = has_next ? nxt.A : cA; const char* nB = has_next ? nxt.B : cB;
        for (int t = 0; t < nt; t += 2) {
            const bool last = (t == nt - 2);
            const char* a1 = cA + (size_t)(t + 1) * kstep;
            const char* a2 = last ? nA : cA + (size_t)(t + 2) * kstep; const char* b2 = last ? nB : cB + (size_t)(t + 2) * kstep;
            const char* a3 = a2 + kstep; const char* b3 = b2 + kstep;
            PG8_LDB(B0, 0, 0); PG8_SCHED; PG8_LDA(At, 0, 0); PG8_STAGE(PG8_SA(1, 1), a1 + hstep, voffA);
            PG8_WAIT_L(8); PG8_BAR; PG8_WAIT_L(0); PG8_MMA(0, 0, At, B0); PG8_BAR; PG8_SCHED;
            PG8_LDB(B1, 0, 1); PG8_STAGE(PG8_SB(0, 0), b2, voffB);
            PG8_BAR; PG8_WAIT_L(0); PG8_MMA(0, 1, At, B1); PG8_BAR;
            PG8_LDA(At, 0, 1); PG8_STAGE(PG8_SA(0, 0), a2, voffA);
            PG8_BAR; PG8_WAIT_L(0); PG8_MMA(1, 0, At, B0); PG8_BAR; PG8_SCHED;
            PG8_STAGE(PG8_SB(0, 1), b2 + hstep, voffB);
            PG8_WAIT_V(6); PG8_BAR; PG8_MMA(1, 1, At, B1); PG8_BAR;
            PG8_LDB(B0, 1, 0); PG8_SCHED; PG8_LDA(At, 1, 0); PG8_STAGE(PG8_SA(0, 1), a2 + hstep, voffA);
            PG8_WAIT_L(8); PG8_BAR; PG8_WAIT_L(0); PG8_MMA(0, 0, At, B0); PG8_BAR; PG8_SCHED;
            PG8_LDB(B1, 1, 1); PG8_STAGE(PG8_SB(1, 0), b3, voffB);
            PG8_BAR; PG8_WAIT_L(0); PG8_MMA(0, 1, At, B1); PG8_BAR;
            PG8_LDA(At, 1, 1); PG8_STAGE(PG8_SA(1, 0), a3, voffA);
            PG8_BAR; PG8_WAIT_L(0); PG8_MMA(1, 0, At, B0); PG8_BAR; PG8_SCHED;
            PG8_STAGE(PG8_SB(1, 1), b3 + hstep, voffB);
            PG8_WAIT_V(6); PG8_BAR; PG8_MMA(1, 1, At, B1); PG8_BAR;
        }
        E(acc, cur, wr, wc, fr, fq);
        if (!has_next) break;
#pragma unroll
        for (int a = 0; a < 2; ++a)
#pragma unroll
            for (int b = 0; b < 2; ++b)
#pragma unroll
                for (int m = 0; m < 4; ++m)
#pragma unroll
                    for (int n = 0; n < 2; ++n) acc[a][b][m][n] = (f32x4){0.f, 0.f, 0.f, 0.f};
        cur = nxt; cA = nA; cB = nB; ++ui;
    }
    PG8_WAIT_V(0);
    if (wr == 0) PG8_BAR;
    PG8_BAR;
#undef PG8_SA
#undef PG8_SB
#undef PG8_STAGE
#undef PG8_LDA
#undef PG8_LDB
#undef PG8_MMA
#undef PG8_WAIT_V
#undef PG8_WAIT_L
#undef PG8_BAR
#undef PG8_SCHED
}
}
using pg8::Unit;

struct SchedG1 {
    const char *xb, *win; char *qk, *vt, *gt; int G, c;
    __device__ __forceinline__ bool next(int i, Unit& u) const {
        const int L = i * G + c; if (L >= 768) return false;
        u.R = nullptr; u.aux = 0;
        if (L < 640) { const int pm = L / 10, pn = L % 10; u.A = xb + (size_t)pm * 256 * 2048;
            if (pn < 4) { u.B = win + (size_t)pn * 256 * 2048; u.O = qk + ((size_t)pm * 256 * 1024 + pn * 256) * 2; u.ldc = 1024; }
            else { u.B = win + (size_t)(1536 + (pn - 4) * 256) * 2048; u.O = gt + ((size_t)pm * 256 * 1536 + (pn - 4) * 256) * 2; u.ldc = 1536; } }
        else { const int v = L - 640, pmv = v >> 6, pnv = v & 63; u.A = win + (size_t)(1024 + pmv * 256) * 2048; u.B = xb + (size_t)pnv * 256 * 2048;
            u.O = vt + ((size_t)pmv * 256 * SEQ + pnv * 256) * 2; u.ldc = SEQ; }
        return true;
    }
};
struct SchedRes {
    const char *a, *b; char* z; const char* r; int K, G, c;
    __device__ __forceinline__ bool next(int i, Unit& u) const {
        const int L = i * G + c; if (L >= 256) return false;
        const int pm = L >> 2, pn = L & 3;
        u.A = a + (size_t)pm * 256 * K * 2; u.B = b + (size_t)pn * 256 * K * 2; const size_t o = ((size_t)pm * 256 * 1024 + pn * 256) * 4;
        u.O = z + o; u.R = r + o; u.ldc = 1024; u.aux = 0; return true;
    }
};
struct SchedG3 {
    const char *x1b, *wq, *wk, *wv, *memb; char *q2, *kmem, *vmemt; int G, c;
    __device__ __forceinline__ bool next(int i, Unit& u) const {
        const int L = i * G + c; if (L >= 132) return false;
        u.R = nullptr; u.aux = 0;
        if (L < 128) { const int pm = L >> 1, pn = L & 1; u.A = x1b + (size_t)pm * 256 * 2048; u.B = wq + (size_t)pn * 256 * 2048; u.O = q2 + ((size_t)pm * 256 * 512 + pn * 256) * 2; u.ldc = 512; }
        else if (L < 130) { const int pn = L - 128; u.A = memb; u.B = wk + (size_t)pn * 256 * 2048; u.O = kmem + (size_t)pn * 256 * 2; u.ldc = 512; }
        else { const int pm = L - 130; u.A = wv + (size_t)pm * 256 * 2048; u.B = memb; u.O = vmemt + (size_t)pm * 256 * 256 * 2; u.ldc = 256; }
        return true;
    }
};
struct SchedG5 {
    const char *xe, *wgu; char* hid; int G, c;
    __device__ __forceinline__ bool next(int i, Unit& u) const {
        const int L = i * G + c; if (L >= 2048) return false;
        const int e = L >> 7, pm = (L >> 4) & 7, pn = L & 15;
        u.A = xe + (size_t)(e * CAP + pm * 256) * 2048; u.B = wgu + (size_t)(e * 4096 + pn * 256) * 2048;
        u.O = hid + ((size_t)(e * CAP + pm * 256) * FF + pn * 128) * 2; u.R = nullptr; u.ldc = FF; u.aux = 0; return true;
    }
};
struct SchedG6 {
    const char *hid, *wd; char* ye; int G, c;
    __device__ __forceinline__ bool next(int i, Unit& u) const {
        const int L = i * G + c; if (L >= 512) return false;
        const int e = L >> 5, pm = (L >> 2) & 7, pn = L & 3;
        u.A = hid + (size_t)(e * CAP + pm * 256) * 4096; u.B = wd + (size_t)(e * 1024 + pn * 256) * 4096;
        u.O = ye + ((size_t)(e * CAP + pm * 256) * 1024 + pn * 256) * 2; u.R = nullptr; u.ldc = 1024; u.aux = e * CAP + pm * 256; return true;
    }
};

__device__ __forceinline__ void tr_item(const float* __restrict__ src, int ldsrc, int k0, int n0, bf16_t* __restrict__ dst_row0, int lddst, LAS float* scr, int lane) {
    const int g = lane >> 4, l15 = lane & 15;
    f32x4 v[16];
    const float* sp = src + (size_t)(k0 + g) * ldsrc + n0 + 4 * l15;
#pragma unroll
    for (int i = 0; i < 16; ++i) v[i] = __builtin_nontemporal_load((const f32x4*)(sp + (size_t)(4 * i) * ldsrc));
#pragma unroll
    for (int i = 0; i < 16; ++i) {
        LAS float* p = scr + (4 * i + g) * 65 + 4 * l15;
        p[0] = v[i][0]; p[1] = v[i][1]; p[2] = v[i][2]; p[3] = v[i][3];
    }
    asm volatile("s_waitcnt lgkmcnt(0)" ::: "memory");
    const int c = lane & 7;
#pragma unroll
    for (int jj = 0; jj < 8; ++jj) {
        const int n = (lane >> 3) + 8 * jj;
        const LAS float* s = scr + (8 * c) * 65 + n;
        u32x4 o; o.x = pk2(s[0], s[65]); o.y = pk2(s[130], s[195]); o.z = pk2(s[260], s[325]); o.w = pk2(s[390], s[455]);
        *(u32x4*)(dst_row0 + (size_t)n * lddst + k0 + 8 * c) = o;
    }
    asm volatile("s_waitcnt lgkmcnt(0)" ::: "memory");
}
__device__ __forceinline__ void tr_matrix_item(const float* W, int K, int N, bf16_t* WT, int item, LAS float* scr, int lane) {
    const int nb = N / 64, kb = item / nb, n0 = (item % nb) * 64;
    tr_item(W, N, kb * 64, n0, WT + (size_t)n0 * K, K, scr, lane);
}
__device__ __forceinline__ void convert_expert_items(const Params& p, LAS unsigned char* lds, int lo, int hi, int w, int nw, int wave, int lane) {
    unsigned char* ws = p.ws;
    LAS float* scr = (LAS float*)(lds + wave * 16640);
    constexpr int I_EG = 8192;
    for (int it = lo + w; it < hi; it += nw) {
        int r = it;
        if (r < 2 * I_EG) {
            const int up = r >= I_EG; if (up) r -= I_EG;
            const int e = r >> 9, q = r & 511, kb = q >> 5, n0 = (q & 31) * 64;
            const float* src = (up ? p.weu : p.weg) + (size_t)e * 1024 * 2048;
            bf16_t* dst = (bf16_t*)(ws + OFF_WGU) + ((size_t)e * 4096 + (n0 >> 7) * 256 + (n0 & 127) + (up ? 128 : 0)) * 1024;
            tr_item(src, 2048, kb * 64, n0, dst, 1024, scr, lane); continue;
        }
        r -= 2 * I_EG;
        { const int e = r >> 9, q = r & 511;
          tr_matrix_item(p.wed + (size_t)e * 2048 * 1024, 2048, 1024, (bf16_t*)(ws + OFF_WD) + (size_t)e * 1024 * 2048, q, scr, lane); }
    }
}
constexpr int CONV_E1 = 16384, CONV_E2 = 20480, CONV_E3 = 24576;
__device__ __forceinline__ void phase_convert(const Params& p, LAS unsigned char* lds, int gw, int NGW, int gtid, int NT, int wave, int lane) {
    unsigned char* ws = p.ws;
    LAS float* scr = (LAS float*)(lds + wave * 16640);
    constexpr int I_WIN = 16 * 48, I_WOUT = 256, I_WQ = 128, I_WMO = 128;
    constexpr int NITEMS = I_WIN + I_WOUT + 3 * I_WQ + I_WMO;
    for (int it = gw; it < NITEMS; it += NGW) {
        int r = it;
        if (r < I_WIN) { tr_matrix_item(p.w_in, 1024, 3072, (bf16_t*)(ws + OFF_WIN), r, scr, lane); continue; } r -= I_WIN;
        if (r < I_WOUT) { tr_matrix_item(p.w_out, 1024, 1024, (bf16_t*)(ws + OFF_WOUT), r, scr, lane); continue; } r -= I_WOUT;
        if (r < I_WQ) { tr_matrix_item(p.wq, 1024, 512, (bf16_t*)(ws + OFF_WQ), r, scr, lane); continue; } r -= I_WQ;
        if (r < I_WQ) { tr_matrix_item(p.wk, 1024, 512, (bf16_t*)(ws + OFF_WK), r, scr, lane); continue; } r -= I_WQ;
        if (r < I_WQ) { tr_matrix_item(p.wv, 1024, 512, (bf16_t*)(ws + OFF_WV), r, scr, lane); continue; } r -= I_WQ;
        tr_matrix_item(p.wmo, 512, 1024, (bf16_t*)(ws + OFF_WMO), r, scr, lane);
    }
    constexpr int NX = SEQ * DM / 8, NM = MEMLEN * DM / 8;
    for (int it = gtid; it < NX + NM; it += NT) {
        const float* s; bf16_t* d;
        if (it < NX) { s = p.x + (size_t)it * 8; d = (bf16_t*)(ws + OFF_XB) + (size_t)it * 8; }
        else { s = p.mem + (size_t)(it - NX) * 8; d = (bf16_t*)(ws + OFF_MEMB) + (size_t)(it - NX) * 8; }
        const f32x4 a = *(const f32x4*)s, b = *(const f32x4*)(s + 4);
        u32x4 o; o.x = pk2(a[0], a[1]); o.y = pk2(a[2], a[3]); o.z = pk2(b[0], b[1]); o.w = pk2(b[2], b[3]);
        *(u32x4*)d = o;
    }
    convert_expert_items(p, lds, 0, CONV_E1, (gw + 1536) % NGW, NGW, wave, lane);
}

template <int DH, bool IS_NA, bool KV_LDS>
__device__ __forceinline__ void attn_unit(const bf16_t* __restrict__ Qrow, const bf16_t* __restrict__ Kmat, int kld, const bf16_t* __restrict__ VT, int vld,
                                          int key0, int kstride, bf16_t* __restrict__ Orow, float scale, int lane,
                                          const LAS float* rpbh, int dr0, int qc, int cb, const LAS char* klds = nullptr, const LAS char* vlds = nullptr) {
    constexpr int KP = 272, VP = 528;
    constexpr int KS = DH / 32, MT = DH / 16;
    const int i = lane & 15, g = lane >> 4;
    bf16x8 qf[KS];
#pragma unroll
    for (int s = 0; s < KS; ++s) qf[s] = *(const bf16x8*)(Qrow + 32 * s + 8 * g);
    f32x4 sc[8][2];
    const int krow = 8 * (i >> 2) + (i & 3);
    constexpr int GB = (DH == 64) ? 8 : 4;
    const char* kb = (const char*)Kmat;
    const unsigned klane = (unsigned)((key0 + krow) * kld + 8 * g) * 2u;
#pragma unroll
    for (int j0 = 0; j0 < 8; j0 += GB) {
        bf16x8 kf[GB][2][KS];
        unsigned kl = klane; asm volatile("" : "+v"(kl));
#pragma unroll
        for (int jb = 0; jb < GB; ++jb)
#pragma unroll
            for (int t = 0; t < 2; ++t)
#pragma unroll
                for (int s = 0; s < KS; ++s) {
                    if (KV_LDS) kf[jb][t][s] = *(const LAS bf16x8*)(klds + (i * KP + 16 * g) + ((32 * (j0 + jb) + 16 * t) * KP + 64 * s));
                    else kf[jb][t][s] = *(const bf16x8*)(kb + (kl + (unsigned)(((j0 + jb) * kstride + 4 * t) * kld + 32 * s) * 2u));
                }
#pragma unroll
        for (int jb = 0; jb < GB; ++jb)
#pragma unroll
            for (int t = 0; t < 2; ++t) {
                f32x4 a = {0.f, 0.f, 0.f, 0.f};
#pragma unroll
                for (int s = 0; s < KS; ++s) a = __builtin_amdgcn_mfma_f32_16x16x32_bf16(kf[jb][t][s], qf[s], a, 0, 0, 0);
                sc[j0 + jb][t] = a;
            }
        __builtin_amdgcn_sched_barrier(0);
    }
    const char* vb = (const char*)VT;
    const unsigned vlane = (unsigned)(i * vld + key0 + 8 * g) * 2u;
    bf16x8 vf[GB][MT];
    { unsigned vl = vlane; asm volatile("" : "+v"(vl));
#pragma unroll
      for (int jb = 0; jb < GB; ++jb)
#pragma unroll
        for (int mt = 0; mt < MT; ++mt) {
            if (KV_LDS) vf[jb][mt] = *(const LAS bf16x8*)(vlds + (i * VP + 16 * g) + (16 * mt * VP + 64 * jb));
            else vf[jb][mt] = *(const bf16x8*)(vb + (vl + (unsigned)(16 * mt * vld + jb * kstride) * 2u));
        } }
    __builtin_amdgcn_sched_barrier(0);
    const int cs = min(max(qc - 8, 0), 48);
    float mx = -1e30f;
#pragma unroll
    for (int j = 0; j < 8; ++j)
#pragma unroll
        for (int t = 0; t < 2; ++t)
#pragma unroll
            for (int jj = 0; jj < 4; ++jj) {
                float v = sc[j][t][jj] * scale;
                if (IS_NA) {
                    const int kc = cb + 8 * g + 4 * t + jj;
                    const bool valid = (kc >= cs) && (kc < cs + 16);
                    const int dc = min(max(kc - qc + 15, 0), 30);
                    v += rpbh[(dr0 + j) * 31 + dc];
                    v = valid ? v : -1e30f;
                }
                sc[j][t][jj] = v; mx = fmaxf(mx, v);
            }
    mx = fmaxf(mx, __shfl_xor(mx, 16)); mx = fmaxf(mx, __shfl_xor(mx, 32));
    float l = 0.f;
#pragma unroll
    for (int j = 0; j < 8; ++j)
#pragma unroll
        for (int t = 0; t < 2; ++t)
#pragma unroll
            for (int jj = 0; jj < 4; ++jj) { const float pv = __expf(sc[j][t][jj] - mx); sc[j][t][jj] = pv; l += pv; }
    l += __shfl_xor(l, 16); l += __shfl_xor(l, 32);
    f32x4 o[MT];
#pragma unroll
    for (int mt = 0; mt < MT; ++mt) o[mt] = (f32x4){0.f, 0.f, 0.f, 0.f};
#pragma unroll
    for (int j0 = 0; j0 < 8; j0 += GB) {
        if (j0 > 0) {
            unsigned vl = vlane; asm volatile("" : "+v"(vl));
#pragma unroll
            for (int jb = 0; jb < GB; ++jb)
#pragma unroll
                for (int mt = 0; mt < MT; ++mt) {
                    if (KV_LDS) vf[jb][mt] = *(const LAS bf16x8*)(vlds + (i * VP + 16 * g) + (16 * mt * VP + 64 * (j0 + jb)));
                    else vf[jb][mt] = *(const bf16x8*)(vb + (vl + (unsigned)(16 * mt * vld + (j0 + jb) * kstride) * 2u));
                }
        }
#pragma unroll
        for (int jb = 0; jb < GB; ++jb) {
            const int j = j0 + jb;
            u32x4 pw; pw.x = pk2(sc[j][0][0], sc[j][0][1]); pw.y = pk2(sc[j][0][2], sc[j][0][3]); pw.z = pk2(sc[j][1][0], sc[j][1][1]); pw.w = pk2(sc[j][1][2], sc[j][1][3]);
            const bf16x8 pf = __builtin_bit_cast(bf16x8, pw);
#pragma unroll
            for (int mt = 0; mt < MT; ++mt) o[mt] = __builtin_amdgcn_mfma_f32_16x16x32_bf16(vf[jb][mt], pf, o[mt], 0, 0, 0);
        }
        __builtin_amdgcn_sched_barrier(0);
    }
    const float inv = 1.f / l;
#pragma unroll
    for (int mt = 0; mt < MT; ++mt) {
        u32x2 w; w.x = pk2(o[mt][0] * inv, o[mt][1] * inv); w.y = pk2(o[mt][2] * inv, o[mt][3] * inv);
        *(u32x2*)(Orow + 16 * mt + 4 * g) = w;
    }
}

__device__ __forceinline__ void phase_mixer(const Params& p, LAS unsigned char* lds, int gw, int NGW, int gtid, int NT, int lane) {
    unsigned char* ws = p.ws;
    LAS float* rpbl = (LAS float*)lds;
    for (int i = threadIdx.x; i < 8 * 15 * 31; i += blockDim.x) rpbl[i] = p.rpb[i];
    __syncthreads();
    const bf16_t* QK = (const bf16_t*)(ws + OFF_QK); const bf16_t* VT = (const bf16_t*)(ws + OFF_VT); const bf16_t* GT = (const bf16_t*)(ws + OFF_GT);
    bf16_t* Y = (bf16_t*)(ws + OFF_Y);
    { const int c = blockIdx.x, G = gridDim.x, wave = __builtin_amdgcn_readfirstlane(threadIdx.x >> 6), h = c & 7;
      for (int rp = c >> 3; rp < 128; rp += (G >> 3)) {
        const int r = 2 * rp + (wave >> 2), qb = wave & 3;
        const int wr0 = min(max(r - 4, 0), 248);
        const int cb = (qb == 0) ? 0 : (qb == 1) ? 8 : (qb == 2) ? 24 : 32;
        const int qc = qb * 16 + (lane & 15), tq = r * 64 + qc;
        attn_unit<64, true, false>(QK + (size_t)tq * 1024 + h * 64, QK + 512 + h * 64, 1024, VT + (size_t)h * 64 * SEQ, SEQ, wr0 * 64 + cb, 64,
                            Y + (size_t)tq * 1024 + h * 64, 0.125f, lane, rpbl + h * 465, wr0 - r + 7, qc, cb);
      } }
    for (int it = gtid; it < SEQ * 64; it += NT) {
        const int t = it >> 6, c8 = (it & 63) * 8;
        float accv[8];
#pragma unroll
        for (int e = 0; e < 8; ++e) accv[e] = 0.f;
#pragma unroll
        for (int dt = 0; dt < 3; ++dt) {
            const int tt = t + dt - 1;
            if (tt >= 0 && tt < SEQ) {
                const u32x4 cg4 = *(const u32x4*)(GT + (size_t)tt * 1536 + 512 + c8), h4 = *(const u32x4*)(GT + (size_t)tt * 1536 + 1024 + c8);
                const f32x4 w0 = *(const f32x4*)(p.conv_w + dt * 512 + c8), w1 = *(const f32x4*)(p.conv_w + dt * 512 + c8 + 4);
                accv[0] += w0[0] * bflo(cg4.x) * bflo(h4.x); accv[1] += w0[1] * bfhi(cg4.x) * bfhi(h4.x);
                accv[2] += w0[2] * bflo(cg4.y) * bflo(h4.y); accv[3] += w0[3] * bfhi(cg4.y) * bfhi(h4.y);
                accv[4] += w1[0] * bflo(cg4.z) * bflo(h4.z); accv[5] += w1[1] * bfhi(cg4.z) * bfhi(h4.z);
                accv[6] += w1[2] * bflo(cg4.w) * bflo(h4.w); accv[7] += w1[3] * bfhi(cg4.w) * bfhi(h4.w);
            }
        }
        const u32x4 b4 = *(const u32x4*)(GT + (size_t)t * 1536 + c8);
        u32x4 o;
        o.x = pk2(accv[0] * bflo(b4.x), accv[1] * bfhi(b4.x)); o.y = pk2(accv[2] * bflo(b4.y), accv[3] * bfhi(b4.y));
        o.z = pk2(accv[4] * bflo(b4.z), accv[5] * bfhi(b4.z)); o.w = pk2(accv[6] * bflo(b4.w), accv[7] * bfhi(b4.w));
        *(u32x4*)(Y + (size_t)t * 1024 + 512 + c8) = o;
    }
}

__device__ __forceinline__ void phase_xattn(const Params& p, LAS unsigned char* lds, int lane) {
    unsigned char* ws = p.ws;
    const bf16_t* Q2 = (const bf16_t*)(ws + OFF_Q2); const bf16_t* KM = (const bf16_t*)(ws + OFF_KMEM); const bf16_t* VM = (const bf16_t*)(ws + OFF_VMEMT);
    bf16_t* O = (bf16_t*)(ws + OFF_O);
    const int c = blockIdx.x, G = gridDim.x, tid = threadIdx.x, wave = __builtin_amdgcn_readfirstlane(tid >> 6), h = c & 3;
    LAS char* kl = (LAS char*)lds; LAS char* vl = (LAS char*)lds + 256 * 272;
#pragma unroll
    for (int ps = 0; ps < 8; ++ps) {
        const int key = ps * 32 + (tid >> 4), ch = tid & 15;
        const int kk = key & 31, slot = (key & ~31) + 16 * ((kk >> 2) & 1) + 4 * (kk >> 3) + (kk & 3);
        const u32x4 kv = *(const u32x4*)(KM + (size_t)key * 512 + h * 128 + ch * 8);
        *(LAS u32x4*)(kl + slot * 272 + ch * 16) = kv;
        const int d = ps * 16 + (tid >> 5), ch2 = tid & 31;
        const u32x4 vv = *(const u32x4*)(VM + (size_t)(h * 128 + d) * 256 + ch2 * 8);
        *(LAS u32x4*)(vl + d * 528 + ch2 * 16) = vv;
    }
    __syncthreads();
    for (int tb = (c >> 2) * 8 + wave; tb < SEQ / 16; tb += (G >> 2) * 8) {
        const int tq = tb * 16 + (lane & 15);
        attn_unit<128, false, true>(Q2 + (size_t)tq * 512 + h * 128, KM + h * 128, 512, VM + (size_t)h * 128 * 256, 256, 0, 32,
                              O + (size_t)tq * 512 + h * 128, 0.08838834764831845f, lane, nullptr, 0, 0, 0, kl, vl);
    }
}

__device__ __forceinline__ void ln_row(f32x4 (&v)[4], const float* __restrict__ gm, const float* __restrict__ bt, int lane) {
    float s = 0.f;
#pragma unroll
    for (int j = 0; j < 4; ++j) s += (v[j][0] + v[j][1]) + (v[j][2] + v[j][3]);
    const float mean = wave_sum(s) * (1.f / DM);
    float s2 = 0.f;
#pragma unroll
    for (int j = 0; j < 4; ++j) { v[j] = v[j] - mean; s2 += (v[j][0] * v[j][0] + v[j][1] * v[j][1]) + (v[j][2] * v[j][2] + v[j][3] * v[j][3]); }
    const float rstd = 1.f / sqrtf(wave_sum(s2) * (1.f / DM) + LNEPS);
#pragma unroll
    for (int j = 0; j < 4; ++j) {
        const f32x4 g4 = *(const f32x4*)(gm + 4 * lane + 256 * j), b4 = *(const f32x4*)(bt + 4 * lane + 256 * j);
        v[j] = v[j] * rstd * g4 + b4;
    }
}
__device__ __forceinline__ void store_row_bf16(bf16_t* row, const f32x4 (&v)[4], int lane) {
#pragma unroll
    for (int j = 0; j < 4; ++j) { u32x2 w; w.x = pk2(v[j][0], v[j][1]); w.y = pk2(v[j][2], v[j][3]); *(u32x2*)(row + 4 * lane + 256 * j) = w; }
}
__device__ __forceinline__ void phase_ln1(const Params& p, int gw, int NGW, int lane) {
    float* Z = (float*)(p.ws + OFF_RB); bf16_t* XB = (bf16_t*)(p.ws + OFF_XB);
    for (int row = gw; row < SEQ; row += NGW) {
        float* zr = Z + (size_t)row * DM; f32x4 v[4];
#pragma unroll
        for (int j = 0; j < 4; ++j) v[j] = *(const f32x4*)(zr + 4 * lane + 256 * j);
        ln_row(v, p.ln1g, p.ln1b, lane);
#pragma unroll
        for (int j = 0; j < 4; ++j) *(f32x4*)(zr + 4 * lane + 256 * j) = v[j];
        store_row_bf16(XB + (size_t)row * DM, v, lane);
    }
}
__device__ __forceinline__ void phase_ln2_router(const Params& p, LAS unsigned char* lds, int gw, int NGW, int lane) {
    LAS float* wT = (LAS float*)lds;
    for (int i = threadIdx.x; i < DM * NEXP; i += blockDim.x) wT[(i & 15) * DM + (i >> 4)] = p.w_router[i];
    __syncthreads();
    float* Z = p.out; bf16_t* XB = (bf16_t*)(p.ws + OFF_X2B); float* affT = (float*)(p.ws + OFF_AFFT);
    for (int row = gw; row < SEQ; row += NGW) {
        float* zr = Z + (size_t)row * DM; f32x4 v[4];
#pragma unroll
        for (int j = 0; j < 4; ++j) v[j] = *(const f32x4*)(zr + 4 * lane + 256 * j);
        ln_row(v, p.ln2g, p.ln2b, lane);
#pragma unroll
        for (int j = 0; j < 4; ++j) *(f32x4*)(zr + 4 * lane + 256 * j) = v[j];
        store_row_bf16(XB + (size_t)row * DM, v, lane);
        float lg[NEXP];
#pragma unroll
        for (int e = 0; e < NEXP; ++e) {
            float a = 0.f;
#pragma unroll
            for (int j = 0; j < 4; ++j) { const f32x4 w = *(const LAS f32x4*)(wT + e * DM + 4 * lane + 256 * j); a += (v[j][0] * w[0] + v[j][1] * w[1]) + (v[j][2] * w[2] + v[j][3] * w[3]); }
            lg[e] = wave_sum(a);
            __builtin_amdgcn_sched_barrier(0);
        }
        float mx = lg[0];
#pragma unroll
        for (int e = 1; e < NEXP; ++e) mx = fmaxf(mx, lg[e]);
        float sum = 0.f;
#pragma unroll
        for (int e = 0; e < NEXP; ++e) { lg[e] = expf(lg[e] - mx); sum += lg[e]; }
        float mine = 0.f;
#pragma unroll
        for (int e = 0; e < NEXP; ++e) mine = (lane == e) ? lg[e] : mine;
        if (lane < NEXP) affT[(size_t)lane * SEQ + row] = mine / sum;
    }
}
__device__ __forceinline__ void phase_final(const Params& p, int gw, int NGW, int lane) {
    float* Z = p.out; const bf16_t* YE = (const bf16_t*)(p.ws + OFF_RB); const int* inv = (const int*)(p.ws + OFF_INV); const float* gate = (const float*)(p.ws + OFF_GATE);
    for (int row = gw; row < SEQ; row += NGW) {
        float* zr = Z + (size_t)row * DM; f32x4 v[4];
#pragma unroll
        for (int j = 0; j < 4; ++j) v[j] = *(const f32x4*)(zr + 4 * lane + 256 * j) * ALPHA;
        const int myinv = (lane < NEXP) ? inv[(size_t)row * NEXP + lane] : -1;
        const float mygate = (myinv >= 0) ? gate[lane * CAP + myinv] : 0.f;
#pragma unroll
        for (int e = 0; e < NEXP; ++e) {
            const int slot = __builtin_amdgcn_readlane(myinv, e);
            if (slot >= 0) {
                const float gt = __builtin_bit_cast(float, __builtin_amdgcn_readlane(__builtin_bit_cast(int, mygate), e));
                const bf16_t* yr = YE + (size_t)(e * CAP + slot) * DM;
#pragma unroll
                for (int j = 0; j < 4; ++j) { const u32x2 w = *(const u32x2*)(yr + 4 * lane + 256 * j); v[j][0] += gt * bflo(w.x); v[j][1] += gt * bfhi(w.x); v[j][2] += gt * bflo(w.y); v[j][3] += gt * bfhi(w.y); }
            }
        }
        ln_row(v, p.ln3g, p.ln3b, lane);
#pragma unroll
        for (int j = 0; j < 4; ++j) *(f32x4*)(zr + 4 * lane + 256 * j) = v[j];
    }
}

__device__ __forceinline__ int block_excl_scan(int v, LAS int* tmp, int tid) {
    const int lane = tid & 63, wave = tid >> 6;
    int incl = v;
#pragma unroll
    for (int o = 1; o < 64; o <<= 1) { const int t = __shfl_up(incl, o); if (lane >= o) incl += t; }
    __syncthreads();
    if (lane == 63) tmp[wave] = incl;
    __syncthreads();
    int base = 0;
#pragma unroll
    for (int w = 0; w < 8; ++w) base += (w < wave) ? tmp[w] : 0;
    return base + incl - v;
}
__device__ __forceinline__ void phase_topk(const Params& p, LAS unsigned char* lds, int e) {
    const int tid = threadIdx.x, lane = tid & 63, wave = tid >> 6;
    LAS unsigned* hist = (LAS unsigned*)lds; LAS unsigned* ctl = hist + 256; LAS int* tmp = (LAS int*)(hist + 272);
    LAS unsigned* vals = hist + 320;
    const unsigned* affT = (const unsigned*)(p.ws + OFF_AFFT) + (size_t)e * SEQ;
    int* idx = (int*)(p.ws + OFF_IDX); float* gate = (float*)(p.ws + OFF_GATE); int* inv = (int*)(p.ws + OFF_INV);
#pragma unroll 4
    for (int k = 0; k < 32; ++k) { const int t = k * 512 + tid; vals[t + (t >> 5)] = affT[t]; }
    __syncthreads();
    const LAS unsigned* mine = vals + tid * 33;
    unsigned prefix = 0, need = CAP;
#pragma unroll 1
    for (int ps = 3; ps >= 0; --ps) {
        const int shift = 8 * ps;
        const unsigned maskhi = (ps == 3) ? 0u : (0xFFFFFFFFu << (shift + 8));
        if (tid < 256) hist[tid] = 0;
        __syncthreads();
#pragma unroll 4
        for (int i = 0; i < 32; ++i) { const unsigned x = mine[i]; if ((x & maskhi) == prefix) __hip_atomic_fetch_add(&hist[(x >> shift) & 255], 1u, __ATOMIC_RELAXED, __HIP_MEMORY_SCOPE_WORKGROUP); }
        __syncthreads();
        if (wave == 0) {
            const unsigned c0 = hist[255 - 4 * lane], c1 = hist[254 - 4 * lane], c2 = hist[253 - 4 * lane], c3 = hist[252 - 4 * lane];
            const unsigned s = c0 + c1 + c2 + c3;
            unsigned incl = s;
#pragma unroll
            for (int o = 1; o < 64; o <<= 1) { const unsigned t = __shfl_up(incl, o); if (lane >= o) incl += t; }
            const unsigned excl = incl - s;
            if (excl < need && need <= incl) {
                unsigned rem = need - excl; int bin;
                if (rem <= c0) bin = 255 - 4 * lane;
                else { rem -= c0; if (rem <= c1) bin = 254 - 4 * lane; else { rem -= c1; if (rem <= c2) bin = 253 - 4 * lane; else { rem -= c2; bin = 252 - 4 * lane; } } }
                ctl[0] = prefix | ((unsigned)bin << shift); ctl[1] = rem;
            }
        }
        __syncthreads();
        prefix = ctl[0]; need = ctl[1];
        __syncthreads();
    }
    const unsigned T = prefix;
    int ngt = 0, neq = 0;
#pragma unroll 4
    for (int i = 0; i < 32; ++i) { const unsigned x = mine[i]; ngt += (x > T) ? 1 : 0; neq += (x == T) ? 1 : 0; }
    const int eq_before = block_excl_scan(neq, tmp, tid);
    const int take_eq = min(max((int)need - eq_before, 0), neq);
    const int sel_before = block_excl_scan(ngt + take_eq, tmp, tid);
    int slot = sel_before, eqr = eq_before;
#pragma unroll 2
    for (int i = 0; i < 32; ++i) {
        const int t = tid * 32 + i;
        const unsigned x = mine[i];
        const bool iseq = (x == T);
        const bool sl = (x > T) || (iseq && eqr < (int)need);
        eqr += iseq ? 1 : 0;
        if (sl) { idx[e * CAP + slot] = t; gate[e * CAP + slot] = __uint_as_float(x); ++slot; }
        inv[(size_t)t * NEXP + e] = sl ? (slot - 1) : -1;
    }
}
__device__ __forceinline__ void phase_gather(const Params& p, int gw, int NGW, int lane) {
    const bf16_t* XB = (const bf16_t*)(p.ws + OFF_X2B); bf16_t* XE = (bf16_t*)(p.ws + OFF_RB); const int* idx = (const int*)(p.ws + OFF_IDX);
    for (int row = gw; row < NEXP * CAP; row += NGW) {
        const int t = idx[row];
        const u32x4* s = (const u32x4*)(XB + (size_t)t * DM); u32x4* d = (u32x4*)(XE + (size_t)row * DM);
        const u32x4 a = s[lane], b = s[64 + lane];
        d[lane] = a; d[64 + lane] = b;
    }
}


#define XB_TMO      128
#define XB_XCNT(j)  (256  + 64 * (j))
#define XB_XSUB(j)  (1280 + 64 * (j))
#define XB_XGEN(j)  (2304 + 64 * (j))
#define XB_TOP      3328
#define XB_TOPGEN   3392
#define XCD_BAR_WORDS 3456
#define XB_SPIN_CAP (1u << 18)
__device__ __forceinline__ unsigned xb_ld(unsigned* p)              { return __hip_atomic_load(p, __ATOMIC_RELAXED, __HIP_MEMORY_SCOPE_AGENT); }
__device__ __forceinline__ unsigned xb_add(unsigned* p, unsigned v) { return __hip_atomic_fetch_add(p, v, __ATOMIC_RELAXED, __HIP_MEMORY_SCOPE_AGENT); }
__device__ __forceinline__ unsigned xb_xcc_id() { return (unsigned)__builtin_amdgcn_s_getreg((3 << 11) | 20) & 0xFu; }
#define XB_SPIN(cond, bar) do { unsigned _sp = 0; while (cond) { __builtin_amdgcn_s_sleep(1); \
    if ((++_sp & 255u) == 0u) { if (xb_ld(&(bar)[XB_TMO])) break; if (_sp > XB_SPIN_CAP) { atomicAdd(&(bar)[XB_TMO], 1u); break; } } } } while (0)
struct XcdBarrier { unsigned* bar; unsigned x; volatile LAS unsigned* st; };
__device__ __forceinline__ XcdBarrier xcd_barrier_post(unsigned* bar, volatile LAS unsigned* st) {
    XcdBarrier b; b.bar = bar; b.x = xb_xcc_id(); b.st = st;
    if (threadIdx.x == 0) (void)xb_add(&bar[XB_XCNT(b.x)], 1u);
    return b;
}
__device__ __forceinline__ void xcd_barrier_complete(unsigned* bar, unsigned x, unsigned& nloc, unsigned& nx) {
    const unsigned G = gridDim.x * gridDim.y * gridDim.z;
    unsigned sum, cnt, mine, sp = 0u;
    for (;;) {
        sum = 0u; cnt = 0u; mine = 0u;
#pragma unroll
        for (unsigned j = 0; j < 16; ++j) { const unsigned c = xb_ld(&bar[XB_XCNT(j)]); sum += c; cnt += (c > 0u) ? 1u : 0u; mine = (j == x) ? c : mine; }
        if (sum == G) break;
        __builtin_amdgcn_s_sleep(1);
        if ((++sp & 255u) == 0u) { if (xb_ld(&bar[XB_TMO])) break; if (sp > XB_SPIN_CAP) { atomicAdd(&bar[XB_TMO], 1u); break; } }
    }
    nloc = mine > 0u ? mine : 1u; nx = cnt > 0u ? cnt : 1u;
}
__device__ __forceinline__ void xcd_barrier(const XcdBarrier& b) {
    asm volatile("s_waitcnt vmcnt(0)" ::: "memory");
    __syncthreads();
    if (threadIdx.x == 0) {
        unsigned* bar = b.bar;
        __builtin_amdgcn_s_waitcnt(0);
        unsigned nloc = b.st[0], nx = b.st[1];
        if (nloc == 0u) { xcd_barrier_complete(bar, b.x, nloc, nx); b.st[0] = nloc; b.st[1] = nx; }
        const unsigned old = xb_add(&bar[XB_XSUB(b.x)], 1u);
        const unsigned gen = old / nloc;
        if (old + 1u == (gen + 1u) * nloc) {
            __builtin_amdgcn_fence(__ATOMIC_RELEASE, "agent");
            asm volatile("s_waitcnt vmcnt(0)" ::: "memory");
            const unsigned og = xb_add(&bar[XB_TOP], 1u);
            const unsigned tg = og / nx;
            if (og + 1u == (tg + 1u) * nx) xb_add(&bar[XB_TOPGEN], 1u);
            else XB_SPIN(xb_ld(&bar[XB_TOPGEN]) == tg, bar);
            __builtin_amdgcn_fence(__ATOMIC_ACQUIRE, "agent");
            xb_add(&bar[XB_XGEN(b.x)], 1u);
            asm volatile("s_waitcnt vmcnt(0)" ::: "memory");
        } else {
            XB_SPIN(xb_ld(&bar[XB_XGEN(b.x)]) == gen, bar);
            __builtin_amdgcn_fence(__ATOMIC_ACQUIRE, "agent");
            asm volatile("s_waitcnt vmcnt(0)" ::: "memory");
        }
    }
    __syncthreads();
}

#ifndef PHMASK
#define PHMASK 0xFFFF
#endif
#ifndef DUPMASK
#define DUPMASK 0
#endif
#ifndef XSYNC
#define XSYNC 0
#endif
#define PH(n) if ((PHMASK >> (n)) & 1)
#define DUP(n) if ((DUPMASK >> (n)) & 1)
__global__ void __launch_bounds__(512, 2) fwd_megakernel(Params p_arg) {
    const Params& p = *(const Params*)__builtin_amdgcn_kernarg_segment_ptr();
    extern __shared__ __attribute__((aligned(16))) unsigned char shm[];
    LAS unsigned char* lds = (LAS unsigned char*)shm;
    cg::grid_group grid = cg::this_grid();
    volatile LAS unsigned* xst = (volatile LAS unsigned*)(lds + LDS_BYTES - 16);
    if (threadIdx.x == 0) { xst[0] = 0u; xst[1] = 0u; }
    __syncthreads();
    (void)xcd_barrier_post((unsigned*)(p.ws + OFF_CTL), xst);
#define XBAR() do { XcdBarrier _b; _b.bar = (unsigned*)(p.ws + OFF_CTL); _b.x = xb_xcc_id(); _b.st = (volatile LAS unsigned*)(lds + LDS_BYTES - 16); xcd_barrier(_b); } while (0)
    if (p.ws == nullptr) grid.sync();
    const int tid = threadIdx.x, lane = tid & 63, wave = __builtin_amdgcn_readfirstlane(tid >> 6);
    const int G = gridDim.x, c = blockIdx.x;
    const int gw = c * 8 + wave, NGW = G * 8, gtid = c * 512 + tid, NT = G * 512;
    unsigned char* ws = p.ws;

    PH(0) phase_convert(p, lds, gw, NGW, gtid, NT, wave, lane);
    DUP(0) phase_convert(p, lds, gw, NGW, gtid, NT, wave, lane);
    XBAR();
    PH(1) { SchedG1 S{(const char*)(ws + OFF_XB), (const char*)(ws + OFF_WIN), (char*)(ws + OFF_QK), (char*)(ws + OFF_VT), (char*)(ws + OFF_GT), G, c};
      pg8::gemm_phase(lds, 1024, S, pg8::EpiBf16{}); }
    DUP(1) { SchedG1 S{(const char*)(ws + OFF_XB), (const char*)(ws + OFF_WIN), (char*)(ws + OFF_QK), (char*)(ws + OFF_VT), (char*)(ws + OFF_GT), G, c};
      pg8::gemm_phase(lds, 1024, S, pg8::EpiBf16{}); }
    XBAR();
    PH(2) phase_mixer(p, lds, gw, NGW, gtid, NT, lane);
    DUP(2) phase_mixer(p, lds, gw, NGW, gtid, NT, lane);
    XBAR();
    PH(3) { SchedRes S{(const char*)(ws + OFF_Y), (const char*)(ws + OFF_WOUT), (char*)(ws + OFF_RB), (const char*)p.x, 1024, G, c};
      pg8::gemm_phase(lds, 1024, S, pg8::EpiRes{}); }
    DUP(3) { SchedRes S{(const char*)(ws + OFF_Y), (const char*)(ws + OFF_WOUT), (char*)(ws + OFF_RB), (const char*)p.x, 1024, G, c};
      pg8::gemm_phase(lds, 1024, S, pg8::EpiRes{}); }
    XBAR();
    PH(4) phase_ln1(p, gw, NGW, lane);
    DUP(4) phase_ln1(p, gw, NGW, lane);
    XBAR();
    PH(5) { if (c < 132) { SchedG3 S{(const char*)(ws + OFF_XB), (const char*)(ws + OFF_WQ), (const char*)(ws + OFF_WK), (const char*)(ws + OFF_WV), (const char*)(ws + OFF_MEMB),
                (char*)(ws + OFF_Q2), (char*)(ws + OFF_KMEM), (char*)(ws + OFF_VMEMT), G, c};
      pg8::gemm_phase(lds, 1024, S, pg8::EpiBf16{}); }
      else convert_expert_items(p, lds, CONV_E1, CONV_E2, (c - 132) * 8 + wave, (G - 132) * 8, wave, lane); }
    XBAR();
    PH(6) phase_xattn(p, lds, lane);
    DUP(6) phase_xattn(p, lds, lane);
    XBAR();
    PH(7) { SchedRes S{(const char*)(ws + OFF_O), (const char*)(ws + OFF_WMO), (char*)p.out, (const char*)(ws + OFF_RB), 512, G, c};
      pg8::gemm_phase(lds, 512, S, pg8::EpiRes{}); }
    DUP(7) { SchedRes S{(const char*)(ws + OFF_O), (const char*)(ws + OFF_WMO), (char*)p.out, (const char*)(ws + OFF_RB), 512, G, c};
      pg8::gemm_phase(lds, 512, S, pg8::EpiRes{}); }
    XBAR();
    PH(8) phase_ln2_router(p, lds, gw, NGW, lane);
    DUP(8) phase_ln2_router(p, lds, gw, NGW, lane);
    XBAR();
    PH(9) { if (c < NEXP) phase_topk(p, lds, c); else convert_expert_items(p, lds, CONV_E2, CONV_E3, (c - NEXP) * 8 + wave, (G - NEXP) * 8, wave, lane); }
    XBAR();
    PH(10) phase_gather(p, gw, NGW, lane);
    DUP(10) phase_gather(p, gw, NGW, lane);
    XBAR();
    PH(11) { SchedG5 S{(const char*)(ws + OFF_RB), (const char*)(ws + OFF_WGU), (char*)(ws + OFF_HID), G, c};
      pg8::gemm_phase(lds, 1024, S, pg8::EpiSwiGLU{}); }
    DUP(11) { SchedG5 S{(const char*)(ws + OFF_RB), (const char*)(ws + OFF_WGU), (char*)(ws + OFF_HID), G, c};
      pg8::gemm_phase(lds, 1024, S, pg8::EpiSwiGLU{}); }
    XBAR();
    PH(12) { SchedG6 S{(const char*)(ws + OFF_HID), (const char*)(ws + OFF_WD), (char*)(ws + OFF_RB), G, c};
      pg8::gemm_phase(lds, 2048, S, pg8::EpiBf16{}); }
    DUP(12) { SchedG6 S{(const char*)(ws + OFF_HID), (const char*)(ws + OFF_WD), (char*)(ws + OFF_RB), G, c};
      pg8::gemm_phase(lds, 2048, S, pg8::EpiBf16{}); }
    XBAR();
    for (int _x = 0; _x < XSYNC; ++_x) XBAR();
    PH(13) phase_final(p, gw, NGW, lane);
    DUP(13) phase_final(p, gw, NGW, lane);
}

extern "C" void kernel_launch(void* const* d_in, const int* in_sizes, int n_in, void* d_out, int out_size, void* d_ws, size_t ws_size, hipStream_t stream) {
    static int grid_blocks = 0;
    if (grid_blocks == 0) {
        if (n_in != 20 || out_size != SEQ * DM || ws_size < WS_END) { fprintf(stderr, "kernel_launch: unexpected shapes (n_in %d, out %d, ws %zu)\n", n_in, out_size, ws_size); grid_blocks = -1; return; }
        int dev = 0, cus = 0, per_cu = 0;
        hipGetDevice(&dev);
        hipDeviceGetAttribute(&cus, hipDeviceAttributeMultiprocessorCount, dev);
        if (hipFuncSetAttribute((const void*)fwd_megakernel, hipFuncAttributeMaxDynamicSharedMemorySize, LDS_BYTES) != hipSuccess) { fprintf(stderr, "kernel_launch: hipFuncSetAttribute failed\n"); grid_blocks = -1; return; }
        if (hipOccupancyMaxActiveBlocksPerMultiprocessor(&per_cu, (const void*)fwd_megakernel, 512, LDS_BYTES) != hipSuccess || per_cu < 1) per_cu = 1;
        (void)hipGetLastError();
        grid_blocks = cus * per_cu;
    }
    if (grid_blocks < 0) return;
    if (hipMemsetAsync((char*)d_ws + OFF_CTL, 0, XCD_BAR_WORDS * 4, stream) != hipSuccess) { fprintf(stderr, "kernel_launch: memset failed\n"); return; }
    Params p{};
    const float** f = (const float**)&p;
    for (int i = 0; i < 20; ++i) f[i] = (const float*)d_in[i];
    p.out = (float*)d_out; p.ws = (unsigned char*)d_ws;
    void* args[] = {&p};
    hipError_t e = hipLaunchCooperativeKernel((const void*)fwd_megakernel, dim3(grid_blocks), dim3(512), args, LDS_BYTES, stream);
    if (e != hipSuccess) fprintf(stderr, "cooperative launch failed: %s (grid %d)\n", hipGetErrorString(e), grid_blocks);
}
```
